# Optimizing an MI355X kernel written in HIP

```python
import jax
import jax.numpy as jnp
from jax import lax
import numpy as np

D_MODEL = 1024
BATCH = 2
SEQ = 8192
DEPTH = 4
DEC_BATCH = 32
DEC_SEQ = 1
PAST_LEN = 8192
PAGE_SIZE = 128

N_HEADS = 8
HEAD_DIM = 64
D_ATTN = N_HEADS * HEAD_DIM
D_POOL = D_MODEL - D_ATTN
POOL_WINDOWS = (2, 4, 8, 16)
N_POOL_GROUPS = len(POOL_WINDOWS)
POOL_GROUP_DIM = D_POOL // N_POOL_GROUPS
POOL_BUF = max(POOL_WINDOWS) - 1
DILATION_PATTERNS = ((128, 1), (512, 4), (2048, 16))
MAX_WINDOW = max(w for w, _ in DILATION_PATTERNS)
BLOCK = 128
D_IN = 3 * D_ATTN + D_POOL
D_FF = 4 * D_MODEL
D_PLE = 256
EPS = 1e-6
NEG_INF = -1e30
ATTN_SCALE = HEAD_DIM ** -0.5

kernel_name = 'hymba_dilated_pool_decoder_step'


def rmsnorm(x, g):
    xf = x.astype(jnp.float32)
    y = xf * lax.rsqrt(jnp.mean(xf * xf, axis=-1, keepdims=True) + EPS)
    return (y * g.astype(jnp.float32)).astype(x.dtype)


def _project(xn, w_in):
    B, T, _ = xn.shape
    proj = xn @ w_in
    q = proj[..., :D_ATTN].reshape(B, T, N_HEADS, HEAD_DIM)
    k = proj[..., D_ATTN:2 * D_ATTN].reshape(B, T, N_HEADS, HEAD_DIM)
    v = proj[..., 2 * D_ATTN:3 * D_ATTN].reshape(B, T, N_HEADS, HEAD_DIM)
    u = proj[..., 3 * D_ATTN:]
    return q, k, v, u


def _dilated_attn_prompt(q, k, v, window, dil):
    B, S, H, E = q.shape
    span = window // dil
    lc = -(-S // (dil * BLOCK)) * BLOCK
    nb = lc // BLOCK
    pad = lc * dil - S

    def to_classes(t):
        t = jnp.pad(t, ((0, 0), (0, pad), (0, 0), (0, 0)))
        t = t.reshape(B, lc, dil, H, E).transpose(0, 2, 3, 1, 4)
        return t.reshape(B, dil, H, nb, BLOCK, E)

    def with_prev(t):
        prev = jnp.pad(t, ((0, 0), (0, 0), (0, 0), (1, 0), (0, 0), (0, 0)))[:, :, :, :nb]
        return jnp.concatenate([prev, t], axis=4)

    qb = to_classes(q)
    kb = with_prev(to_classes(k))
    vb = with_prev(to_classes(v))
    s = jnp.einsum('bdhnqe,bdhnke->bdhnqk', qb, kb).astype(jnp.float32) * ATTN_SCALE
    qi = jnp.arange(BLOCK)[:, None]
    kj = jnp.arange(2 * BLOCK)[None, :] - BLOCK
    rel = qi - kj
    key_idx = jnp.arange(nb)[:, None, None] * BLOCK + kj[None]
    mask = (rel >= 0) & (rel <= span) & (key_idx >= 0)
    s = jnp.where(mask, s, NEG_INF)
    m = jnp.max(s, axis=-1, keepdims=True)
    p = jnp.exp(s - m)
    den = jnp.sum(p, axis=-1)
    o = jnp.einsum('bdhnqk,bdhnke->bdhnqe', p, vb.astype(jnp.float32)) / den[..., None]
    lse = m[..., 0] + jnp.log(den)
    o = o.reshape(B, dil, H, lc, E).transpose(0, 3, 1, 2, 4).reshape(B, lc * dil, H, E)[:, :S]
    lse = lse.reshape(B, dil, H, lc).transpose(0, 3, 1, 2).reshape(B, lc * dil, H)[:, :S]
    return o, lse


def _dilated_attn_sample(q, k_ext, v_ext, window, dil):
    T = q.shape[1]
    n_hist = k_ext.shape[1] - T
    span = window // dil
    idx = (n_hist + jnp.arange(T))[:, None] - dil * jnp.arange(span + 1)[None, :]
    valid = idx >= 0
    idx = jnp.maximum(idx, 0)
    kg = k_ext[:, idx]
    vg = v_ext[:, idx]
    s = jnp.einsum('bthe,btkhe->bthk', q, kg).astype(jnp.float32) * ATTN_SCALE
    s = jnp.where(valid[None, :, None, :], s, NEG_INF)
    m = jnp.max(s, axis=-1, keepdims=True)
    p = jnp.exp(s - m)
    den = jnp.sum(p, axis=-1)
    o = jnp.einsum('bthk,btkhe->bthe', p, vg.astype(jnp.float32)) / den[..., None]
    lse = m[..., 0] + jnp.log(den)
    return o, lse


def _pool_mix(u_ext, n_new, pool_w, pool_scale):
    B, R, _ = u_ext.shape
    uf = u_ext.astype(jnp.float32)
    cs = jnp.pad(jnp.cumsum(uf, axis=1), ((0, 0), (1, 0), (0, 0)))
    rows = jnp.arange(R - n_new, R)
    cur = uf[:, R - n_new:]
    groups = []
    for g, w in enumerate(POOL_WINDOWS):
        sl = slice(g * POOL_GROUP_DIM, (g + 1) * POOL_GROUP_DIM)
        lo = jnp.maximum(rows + 1 - w, 0)
        cnt = (rows + 1 - lo).astype(jnp.float32)
        mean = (cs[:, rows + 1, sl] - cs[:, lo, sl]) / cnt[None, :, None]
        groups.append(mean - cur[..., sl])
    z = jnp.stack(groups, axis=2)
    y = jnp.einsum('bngc,gcd->bngd', z, pool_w.astype(jnp.float32))
    y = y.reshape(B, n_new, D_POOL) * pool_scale.astype(jnp.float32)
    return y.astype(u_ext.dtype)


def _mixer_out(outs, lses, pooled, w_out):
    wts = jax.nn.softmax(jnp.stack(lses, axis=0), axis=0)
    attn = jnp.einsum('gbth,gbthe->bthe', wts, jnp.stack(outs, axis=0))
    B, T = attn.shape[:2]
    attn = attn.reshape(B, T, D_ATTN).astype(pooled.dtype)
    return jnp.concatenate([attn, pooled], axis=-1) @ w_out


def _mlp(h, g, w_up, w_down):
    a = jax.nn.relu(rmsnorm(h, g) @ w_up)
    return (a * a) @ w_down


def _ple(h, p, g, w_gate, w_ple):
    gate = jax.nn.sigmoid(rmsnorm(h, g) @ w_gate)
    return (p @ w_ple) * gate


def setup_inputs(seed: int = 0) -> dict:
    key = jax.random.key(seed)
    ks = jax.random.split(key, 20)
    nrm = jax.random.normal
    w_buf = min(MAX_WINDOW, PAST_LEN)
    return {
        'x_prompt': nrm(ks[0], (BATCH, SEQ, D_MODEL), jnp.float32),
        'x_sample': nrm(ks[1], (DEC_BATCH, DEC_SEQ, D_MODEL), jnp.float32),
        'cache_attn_kv': nrm(ks[2], (DEPTH, DEC_BATCH, w_buf, 2, N_HEADS, HEAD_DIM), jnp.float32),
        'state_pool': nrm(ks[3], (DEPTH, DEC_BATCH, POOL_BUF, D_POOL), jnp.float32),
        'p_prompt': nrm(ks[4], (DEPTH, BATCH, SEQ, D_PLE), jnp.float32),
        'p_sample': nrm(ks[5], (DEPTH, DEC_BATCH, DEC_SEQ, D_PLE), jnp.float32),
        'norm_attn_g': 1.0 + 0.05 * nrm(ks[6], (DEPTH, D_MODEL), jnp.float32),
        'w_in': nrm(ks[7], (DEPTH, D_MODEL, D_IN), jnp.float32) * D_MODEL ** -0.5,
        'pool_w': nrm(ks[8], (DEPTH, N_POOL_GROUPS, POOL_GROUP_DIM, POOL_GROUP_DIM), jnp.float32) * POOL_GROUP_DIM ** -0.5,
        'pool_scale': 1.0 + 0.1 * nrm(ks[9], (DEPTH, D_POOL), jnp.float32),
        'w_out': nrm(ks[10], (DEPTH, D_MODEL, D_MODEL), jnp.float32) * D_MODEL ** -0.5,
        'norm_mlp_g': 1.0 + 0.05 * nrm(ks[11], (DEPTH, D_MODEL), jnp.float32),
        'w_up': nrm(ks[12], (DEPTH, D_MODEL, D_FF), jnp.float32) * D_MODEL ** -0.5,
        'w_down': nrm(ks[13], (DEPTH, D_FF, D_MODEL), jnp.float32) * D_FF ** -0.5,
        'ple_norm_g': 1.0 + 0.05 * nrm(ks[14], (DEPTH, D_MODEL), jnp.float32),
        'w_ple_gate': nrm(ks[15], (DEPTH, D_MODEL, D_MODEL), jnp.float32) * D_MODEL ** -0.5,
        'w_ple': nrm(ks[16], (DEPTH, D_PLE, D_MODEL), jnp.float32) * D_PLE ** -0.5,
        'final_norm_g': 1.0 + 0.05 * nrm(ks[17], (D_MODEL,), jnp.float32),
    }


def reference(x_prompt, x_sample, cache_attn_kv, state_pool, p_prompt, p_sample,
              norm_attn_g, w_in, pool_w, pool_scale, w_out, norm_mlp_g, w_up, w_down,
              ple_norm_g, w_ple_gate, w_ple, final_norm_g):
    hp = x_prompt
    hs = x_sample
    S = x_prompt.shape[1]
    T = x_sample.shape[1]
    kv_keep = min(MAX_WINDOW, S)
    kv_p_list, kv_s_list, pool_p_list, pool_s_list = [], [], [], []
    for i in range(DEPTH):
        q, k, v, u = _project(rmsnorm(hp, norm_attn_g[i]), w_in[i])
        outs, lses = [], []
        for window, dil in DILATION_PATTERNS:
            o, l = _dilated_attn_prompt(q, k, v, window, dil)
            outs.append(o)
            lses.append(l)
        pooled = _pool_mix(u, S, pool_w[i], pool_scale[i])
        hp = hp + _mixer_out(outs, lses, pooled, w_out[i])
        hp = hp + _mlp(hp, norm_mlp_g[i], w_up[i], w_down[i])
        hp = hp + _ple(hp, p_prompt[i], ple_norm_g[i], w_ple_gate[i], w_ple[i])
        kv_p_list.append(jnp.stack([k, v], axis=2)[:, S - kv_keep:])
        pool_p_list.append(u[:, S - POOL_BUF:])

        q, k, v, u = _project(rmsnorm(hs, norm_attn_g[i]), w_in[i])
        kv_c = cache_attn_kv[i].astype(k.dtype)
        k_ext = jnp.concatenate([kv_c[:, :, 0], k], axis=1)
        v_ext = jnp.concatenate([kv_c[:, :, 1], v], axis=1)
        outs, lses = [], []
        for window, dil in DILATION_PATTERNS:
            o, l = _dilated_attn_sample(q, k_ext, v_ext, window, dil)
            outs.append(o)
            lses.append(l)
        u_ext = jnp.concatenate([state_pool[i].astype(u.dtype), u], axis=1)
        pooled = _pool_mix(u_ext, T, pool_w[i], pool_scale[i])
        hs = hs + _mixer_out(outs, lses, pooled, w_out[i])
        hs = hs + _mlp(hs, norm_mlp_g[i], w_up[i], w_down[i])
        hs = hs + _ple(hs, p_sample[i], ple_norm_g[i], w_ple_gate[i], w_ple[i])
        kv_s_list.append(jnp.stack([k, v], axis=2))
        pool_s_list.append(u_ext[:, -POOL_BUF:])

    y_prompt = rmsnorm(hp, final_norm_g)
    y_sample = rmsnorm(hs, final_norm_g)
    kv_prompt = jnp.stack(kv_p_list, axis=0)
    kv_sample = jnp.stack(kv_s_list, axis=0)
    pool_prompt = jnp.stack(pool_p_list, axis=0)
    pool_sample = jnp.stack(pool_s_list, axis=0)
    return (y_prompt, y_sample, kv_prompt, kv_sample, pool_prompt, pool_sample)
```

```cpp
#include <hip/hip_runtime.h>
#include <cstdio>
#include <cstdint>
#ifndef MK_SPLIT
#define MK_SPLIT 0
#endif
constexpr int NWAVES = 8;

constexpr int NL = 4, NB = 2, SEQ = 8192, M = NB * SEQ, D = 1024, DIN = 2048, DFF = 4096, DPLE = 256, SB = 32, WBUF = 2048, PBUF = 15, DP = 512;
constexpr float QSCALE = 0.125f * 1.4426950408889634f;
constexpr int N_PHASES = 2 + 6 * NL;
constexpr size_t O_YP = 0, O_YS = (size_t)M * D, O_KVP = O_YS + (size_t)SB * D, O_KVS = O_KVP + (size_t)NL * NB * WBUF * 1024, O_PP = O_KVS + (size_t)NL * SB * 1024,
                 O_PS = O_PP + (size_t)NL * NB * PBUF * DP, O_END = O_PS + (size_t)NL * SB * PBUF * DP;
static_assert(O_END == 34762752, "d_out size");

constexpr size_t MiB = 1u << 20, KiB = 1u << 10;
constexpr size_t WS_CTL = 0, CTL_ZERO_BYTES = 1 * MiB;
constexpr size_t WS_W = 2 * MiB, W_LAYER = 25 * MiB;
constexpr size_t W_IN = 0, W_OUT = 4 * MiB, W_UP = 6 * MiB, W_DN = 14 * MiB, W_GT = 22 * MiB, W_PL = 24 * MiB;
constexpr size_t WS_HB0 = 104 * MiB, WS_HB1 = 136 * MiB;
constexpr size_t WS_H = 168 * MiB;
constexpr size_t WS_QKVU = 232 * MiB;
constexpr size_t WS_AO = 296 * MiB;
constexpr size_t WS_ACT = 328 * MiB;
constexpr size_t WS_PE = 456 * MiB;
constexpr size_t WS_PB = 488 * MiB;
constexpr size_t WS_OPART = 520 * MiB;
constexpr size_t WS_LSE = 568 * MiB;
constexpr size_t WS_SS = 570 * MiB;
constexpr size_t WS_SMP = 572 * MiB;
constexpr size_t WS_END = 576 * MiB;
constexpr size_t SMP_HS = 0, SMP_HSB0 = 128 * KiB, SMP_HSB1 = 192 * KiB, SMP_QS = 256 * KiB, SMP_AOS = 320 * KiB, SMP_ACTS = 384 * KiB, SMP_PSB = 640 * KiB, SMP_SSS = 704 * KiB;
constexpr int CW_TMO = 0, CW_BAR = 4096;

constexpr int RING_OFF = 0, RING_BYTES = 131072;
constexpr int LDSCTL_OFF = RING_BYTES, MISC_OFF = LDSCTL_OFF + 320;
constexpr int LDS_BYTES = 147456;
static_assert(MISC_OFF + 128 <= LDS_BYTES, "LDS map");

#define GAS __attribute__((address_space(1)))
#define LAS __attribute__((address_space(3)))
typedef unsigned short bf16;
typedef unsigned v4u __attribute__((ext_vector_type(4)));
typedef unsigned v2u __attribute__((ext_vector_type(2)));
typedef float f32x4 __attribute__((ext_vector_type(4)));
typedef float f32x16 __attribute__((ext_vector_type(16)));
typedef short bf16x8 __attribute__((ext_vector_type(8)));
typedef short s16x4 __attribute__((ext_vector_type(4)));
typedef GAS unsigned gu32;
#define LDS_WAIT() asm volatile("s_waitcnt lgkmcnt(0)" ::: "memory")
#define VM_WAIT() asm volatile("s_waitcnt vmcnt(0)" ::: "memory")
__device__ __forceinline__ unsigned f2bf(float f) { unsigned u = __builtin_bit_cast(unsigned, f); return (u + 0x7fffu + ((u >> 16) & 1u)) >> 16; }
__device__ __forceinline__ unsigned pk2(float lo, float hi) { return f2bf(lo) | (f2bf(hi) << 16); }
__device__ __forceinline__ float bflo(unsigned w) { return __uint_as_float(w << 16); }
__device__ __forceinline__ float bfhi(unsigned w) { return __uint_as_float(w & 0xffff0000u); }
__device__ __forceinline__ float wave_sum(float v) {
#pragma unroll
    for (int o = 1; o < 64; o <<= 1) v += __shfl_xor(v, o);
    return v;
}

template <int OFF> __device__ __forceinline__ unsigned long long karg64() {
    unsigned long long v;
    asm volatile("s_load_dwordx2 %0, %1, %2\n\ts_waitcnt lgkmcnt(0)" : "=s"(v) : "s"(__builtin_amdgcn_kernarg_segment_ptr()), "i"(OFF));
    return v;
}
#define KIN(i) ((const float*)(const GAS float*)karg64<8 * (i)>())
#define KOUT() ((float*)(GAS float*)karg64<144>())
#define KWS() ((unsigned char*)(GAS unsigned char*)karg64<152>())

namespace pg8 {
#define PG8_LAS __attribute__((address_space(3)))
typedef unsigned short bf16_t;
typedef short bf16x8 __attribute__((ext_vector_type(8)));
typedef float f32x4 __attribute__((ext_vector_type(4)));
typedef unsigned u32x4 __attribute__((ext_vector_type(4)));
constexpr int BM = 256, BK = 64, HALF = 128, HTB = HALF * BK * 2  , STAGE_BYTES = 8 * HTB, NXCD = 8, WGM = 8;

__host__ __device__ __forceinline__ int lds_byte(int r, int c) { const int st = (r >> 4) * 2 + (c >> 5), rr = r & 15, cc = c & 31, ob = rr * 64 + cc * 2; return st * 1024 + (ob ^ (((ob >> 9) & 1) << 5)); }
__host__ __device__ __forceinline__ void stage_rc(int b, int& R, int& C) { const int st = b / 1024, sb = b % 1024, swz = sb ^ (((sb >> 9) & 1) << 5); R = (st >> 1) * 16 + swz / 64; C = (st & 1) * 32 + (swz % 64) / 2; }
__host__ __device__ __forceinline__ int perm32(int rho) { const int n = rho >> 4, i = rho & 15; return 8 * (i >> 2) + 4 * n + (i & 3); }

struct Unit { int pm, pn; };
struct Gemm { const bf16_t* A; const bf16_t* Bt; int M, N, K; };

struct StaticOrder {
    int nM, nN, nwg, G, c;
    __host__ __device__ void init(int M, int N, int G_, int c_) { nM = M / BM; nN = N / BM; nwg = nM * nN; G = G_; c = c_; }
    __host__ __device__ bool next(int i, Unit& u) const {
        const long L = (long)i * G + c; if (L >= nwg) return false;
        int wgid = (int)L; { const int q = nwg / NXCD, r = nwg % NXCD, xcd = wgid % NXCD, off = wgid / NXCD; wgid = (xcd < r ? xcd * (q + 1) : r * (q + 1) + (xcd - r) * q) + off; }
        const int nig = WGM * nN, gid = wgid / nig, fm = gid * WGM, gsz = (nM - fm) < WGM ? (nM - fm) : WGM;
        u.pm = fm + ((wgid % nig) % gsz); u.pn = (wgid % nig) / gsz; return true;
    }
    __device__ __forceinline__ void a_ready(const Unit&) const {}
    __device__ __forceinline__ void done(const Unit&) const {}
};

__device__ __forceinline__ unsigned cvt_pk_bf16(float lo, float hi) { unsigned r; asm volatile("v_cvt_pk_bf16_f32 %0, %1, %2" : "=v"(r) : "v"(lo), "v"(hi)); return r; }
typedef float f32x2 __attribute__((ext_vector_type(2)));
typedef unsigned u32x2 __attribute__((ext_vector_type(2)));
__device__ __forceinline__ u32x4 pack8(const f32x4 a, const f32x4 b) { u32x4 w; w.x = cvt_pk_bf16(a[0], a[1]); w.y = cvt_pk_bf16(a[2], a[3]); w.z = cvt_pk_bf16(b[0], b[1]); w.w = cvt_pk_bf16(b[2], b[3]); return w; }
__device__ __forceinline__ float dot4(const f32x4 a) { return (a[0] * a[0] + a[1] * a[1]) + (a[2] * a[2] + a[3] * a[3]); }
__device__ __forceinline__ float row_rstd(const float* ss, int row) { const f32x4 s = *(const f32x4*)(ss + (size_t)row * 4); return __builtin_amdgcn_rsqf(((s[0] + s[1]) + (s[2] + s[3])) * (1.0f / 1024.0f) + 1e-6f); }
__device__ __forceinline__ void unpack8(const u32x4 w, f32x4& a, f32x4& b) {
    a[0] = __uint_as_float(w.x << 16); a[1] = __uint_as_float(w.x & 0xffff0000u); a[2] = __uint_as_float(w.y << 16); a[3] = __uint_as_float(w.y & 0xffff0000u);
    b[0] = __uint_as_float(w.z << 16); b[1] = __uint_as_float(w.z & 0xffff0000u); b[2] = __uint_as_float(w.w << 16); b[3] = __uint_as_float(w.w & 0xffff0000u); }

struct EpiPlain {
    static constexpr bool PERM = true, AFTER_DRAIN = false;
    int ldc;
    __device__ __forceinline__ void operator()(const f32x4 (&acc)[2][2][4][2], const Unit& u, int wr, int wc, int fr, int fq) const {
        asm volatile("" : "+v"(fr), "+v"(fq));
        bf16_t* O = (bf16_t*)(KWS() + WS_PE);
        const int row0 = u.pm * BM + wr * 64 + fr, col0 = u.pn * BM + wc * 32 + 8 * fq;
#pragma unroll
        for (int ai = 0; ai < 2; ++ai)
#pragma unroll
            for (int m = 0; m < 4; ++m) { bf16_t* rowp = O + (size_t)(row0 + ai * HALF + m * 16) * ldc + col0;
#pragma unroll
                for (int bj = 0; bj < 2; ++bj) *(u32x4*)(rowp + bj * HALF) = pack8(acc[ai][bj][m][0], acc[ai][bj][m][1]); }
    }
};
struct EpiProj {
    static constexpr bool PERM = true, AFTER_DRAIN = false;
    int l;
    __device__ __forceinline__ void operator()(const f32x4 (&acc)[2][2][4][2], const Unit& u, int wr, int wc, int fr, int fq) const {
        asm volatile("" : "+v"(fr), "+v"(fq));
        unsigned char* ws = KWS(); float* outp = KOUT();
        bf16_t* O = (bf16_t*)(ws + WS_QKVU); const float* ss = (const float*)(ws + WS_SS);
        float* kv_out = outp + O_KVP + (size_t)l * NB * WBUF * 1024; float* pool_out = outp + O_PP + (size_t)l * NB * PBUF * DP;
        const int row0 = u.pm * BM + wr * 64 + fr, col0 = u.pn * BM + wc * 32 + 8 * fq;
        const float sc = (u.pn < 2) ? QSCALE : 1.0f;
        const int b = u.pm >> 5, t0 = (u.pm & 31) * BM + wr * 64 + fr;
        const bool kvt = (u.pn >= 2) && (u.pn < 6) && ((u.pm & 31) >= 24);
        const bool plt = (u.pn >= 6) && ((u.pm & 31) == 31);
#pragma unroll
        for (int ai = 0; ai < 2; ++ai)
#pragma unroll
            for (int m = 0; m < 4; ++m) { const int row = row0 + ai * HALF + m * 16, t = t0 + ai * HALF + m * 16;
                const float rs = row_rstd(ss, row);
#pragma unroll
                for (int bj = 0; bj < 2; ++bj) { const int col = col0 + bj * HALF;
                    const f32x4 v0 = acc[ai][bj][m][0] * rs, v1 = acc[ai][bj][m][1] * rs;
                    *(u32x4*)(O + (size_t)row * 2048 + col) = pack8(v0 * sc, v1 * sc);
                    if (kvt) { float* p = kv_out + ((size_t)(b * 2048 + (t - 6144)) * 1024 + (col - 512)); *(f32x4*)p = v0; *(f32x4*)(p + 4) = v1; }
                    if (plt && t >= 8177) { float* p = pool_out + ((size_t)(b * 15 + (t - 8177)) * 512 + (col - 1536)); *(f32x4*)p = v0; *(f32x4*)(p + 4) = v1; } } }
    }
};
struct EpiUp {
    static constexpr bool PERM = true, AFTER_DRAIN = false;
    int l;
    __device__ __forceinline__ void operator()(const f32x4 (&acc)[2][2][4][2], const Unit& u, int wr, int wc, int fr, int fq) const {
        asm volatile("" : "+v"(fr), "+v"(fq));
        unsigned char* ws = KWS();
        bf16_t* O = (bf16_t*)(ws + WS_ACT); const float* ss = (const float*)(ws + WS_SS) + (size_t)M * 4;
        const int row0 = u.pm * BM + wr * 64 + fr, col0 = u.pn * BM + wc * 32 + 8 * fq;
#pragma unroll
        for (int ai = 0; ai < 2; ++ai)
#pragma unroll
            for (int m = 0; m < 4; ++m) { const int row = row0 + ai * HALF + m * 16;
                const float rs = row_rstd(ss, row);
#pragma unroll
                for (int bj = 0; bj < 2; ++bj) {
                    f32x4 v0 = acc[ai][bj][m][0] * rs, v1 = acc[ai][bj][m][1] * rs;
#pragma unroll
                    for (int e = 0; e < 4; ++e) { const float a = fmaxf(v0[e], 0.f), c = fmaxf(v1[e], 0.f); v0[e] = a * a; v1[e] = c * c; }
                    *(u32x4*)(O + (size_t)row * 4096 + col0 + bj * HALF) = pack8(v0, v1); } }
    }
};
__device__ __forceinline__ void ss_finish(PG8_LAS unsigned char* lds, float* ssout, const Unit& u) {
    asm volatile("s_waitcnt lgkmcnt(0)" ::: "memory"); __builtin_amdgcn_s_barrier(); asm volatile("" ::: "memory");
    if (threadIdx.x < 256) { const f32x4 p = *(const PG8_LAS f32x4*)(lds + threadIdx.x * 16); ssout[(size_t)(u.pm * BM + threadIdx.x) * 4 + u.pn] = (p[0] + p[1]) + (p[2] + p[3]); }
}
struct EpiRes {
    static constexpr bool PERM = true, AFTER_DRAIN = true;
    int l, which;
    __device__ __forceinline__ void fused(f32x4 (&acc)[2][2][4][2], const Unit& u, int wr, int wc, int fr, int fq, PG8_LAS unsigned char* lds, int wid, int lane) const {
        asm volatile("" : "+v"(fr), "+v"(fq));
        unsigned char* ws = KWS();
        float* out = (float*)(ws + WS_H); const float* base = (which == 0 && l == 0) ? KIN(0) : (const float*)out;
        bf16_t* hb = (bf16_t*)(ws + ((l & 1) ? WS_HB1 : WS_HB0)); float* ssout = (float*)(ws + WS_SS) + (size_t)(1 + which) * M * 4;
        PG8_LAS float* P = (PG8_LAS float*)lds;
        const int row0 = u.pm * BM + wr * 64 + fr, col0 = u.pn * BM + wc * 32 + 8 * fq;
#pragma unroll
        for (int ai = 0; ai < 2; ++ai)
#pragma unroll
            for (int m = 0; m < 4; ++m) { const size_t off = (size_t)(row0 + ai * HALF + m * 16) * 1024 + col0; float q = 0.f;
#pragma unroll
                for (int bj = 0; bj < 2; ++bj) {
                    const f32x4 o0 = *(const f32x4*)(base + off + bj * HALF) + acc[ai][bj][m][0], o1 = *(const f32x4*)(base + off + bj * HALF + 4) + acc[ai][bj][m][1];
                    *(f32x4*)(out + off + bj * HALF) = o0; *(f32x4*)(out + off + bj * HALF + 4) = o1;
                    *(u32x4*)(hb + off + bj * HALF) = pack8(o0, o1);
                    q += dot4(o0) + dot4(o1); }
                q += __shfl_xor(q, 16); q += __shfl_xor(q, 32);
                if (fq == 0) P[(ai * HALF + wr * 64 + m * 16 + fr) * 4 + wc] = q;
                if (m & 1) asm volatile("" ::: "memory"); }
        ss_finish(lds, ssout, u);
    }
};
struct EpiGate {
    static constexpr bool PERM = true, AFTER_DRAIN = true;
    int l;
    __device__ __forceinline__ void fused(f32x4 (&acc)[2][2][4][2], const Unit& u, int wr, int wc, int fr, int fq, PG8_LAS unsigned char* lds, int wid, int lane) const {
        asm volatile("" : "+v"(fr), "+v"(fq));
        unsigned char* ws = KWS();
        float* out = (float*)(ws + WS_H); const float* base = out; bf16_t* hb = (bf16_t*)(ws + ((l & 1) ? WS_HB0 : WS_HB1)); const bf16_t* pe = (const bf16_t*)(ws + WS_PE);
        const float* ssin = (const float*)(ws + WS_SS) + (size_t)2 * M * 4; float* ssout = (float*)(ws + WS_SS);
        PG8_LAS float* P = (PG8_LAS float*)lds;
        const int row0 = u.pm * BM + wr * 64 + fr, col0 = u.pn * BM + wc * 32 + 8 * fq;
#pragma unroll
        for (int ai = 0; ai < 2; ++ai)
#pragma unroll
            for (int m = 0; m < 4; ++m) { const int row = row0 + ai * HALF + m * 16; const size_t off = (size_t)row * 1024 + col0; float q = 0.f;
                const float rs = row_rstd(ssin, row);
#pragma unroll
                for (int bj = 0; bj < 2; ++bj) {
                    f32x4 p0, p1; unpack8(*(const u32x4*)(pe + off + bj * HALF), p0, p1);
                    f32x4 g0 = acc[ai][bj][m][0] * (rs * -1.4426950408889634f), g1 = acc[ai][bj][m][1] * (rs * -1.4426950408889634f);
#pragma unroll
                    for (int e = 0; e < 4; ++e) { g0[e] = __builtin_amdgcn_rcpf(1.0f + __builtin_amdgcn_exp2f(g0[e])); g1[e] = __builtin_amdgcn_rcpf(1.0f + __builtin_amdgcn_exp2f(g1[e])); }
                    const f32x4 o0 = *(const f32x4*)(base + off + bj * HALF) + p0 * g0, o1 = *(const f32x4*)(base + off + bj * HALF + 4) + p1 * g1;
                    *(f32x4*)(out + off + bj * HALF) = o0; *(f32x4*)(out + off + bj * HALF + 4) = o1;
                    *(u32x4*)(hb + off + bj * HALF) = pack8(o0, o1);
                    q += dot4(o0) + dot4(o1); }
                q += __shfl_xor(q, 16); q += __shfl_xor(q, 32);
                if (fq == 0) P[(ai * HALF + wr * 64 + m * 16 + fr) * 4 + wc] = q;
                if (m & 1) asm volatile("" ::: "memory"); }
        ss_finish(lds, ssout, u);
    }
};

template <class Epi, class Sched, bool ALIGN_EPI = false, bool SP2 = false>
__device__ __forceinline__ void gemm_phase(PG8_LAS unsigned char* lds, const Gemm g, const Sched& S, const Epi& E, int wave_id) {
    int lane = (int)__builtin_amdgcn_mbcnt_hi(~0u, __builtin_amdgcn_mbcnt_lo(~0u, 0u)), widv = wave_id; asm volatile("" : "+v"(lane), "+v"(widv)); const int wid = __builtin_amdgcn_readfirstlane(widv);
    const int tid = wid * 64 + lane, wr = wid >> 2, wc = wid & 3, fr = lane & 15, fq = lane >> 4;
    const int K = g.K, nt = K / BK;
    unsigned voffA[2], voffB[2];
#pragma unroll
    for (int i = 0; i < 2; ++i) { int R, C; stage_rc(tid * 16 + i * 8192, R, C); const int Rb = Epi::PERM ? ((R & ~31) + perm32(R & 31)) : R;
        voffA[i] = (unsigned)(R * K + C) * 2u; voffB[i] = (unsigned)(Rb * K + C) * 2u; }
    const size_t kstep = (size_t)(BK * 2);
    const size_t hstep = (size_t)HALF * K * 2;
    const size_t tstep = 2 * hstep;
    const unsigned ldsw = (unsigned)wid * 1024u;
    const int aoff = lds_byte(wr * 64 + fr, fq * 8), boff = lds_byte(wc * 32 + fr, fq * 8);
#define PG8_SA(b, h) (((b) * 2 + (h)) * HTB)
#define PG8_SB(b, h) ((4 + (b) * 2 + (h)) * HTB)
#define PG8_STAGE(bufoff, gbase, voff) do { _Pragma("unroll") for (int _i = 0; _i < 2; ++_i) \
        __builtin_amdgcn_global_load_lds((const unsigned*)((const char*)(gbase) + (voff)[_i]), (PG8_LAS unsigned*)(lds + (bufoff) + ldsw + _i * 8192), 16, 0, 0); } while (0)
#define PG8_LDA(dst, b, h) do { _Pragma("unroll") for (int m = 0; m < 4; ++m) _Pragma("unroll") for (int k = 0; k < 2; ++k) dst[m][k] = *(const PG8_LAS bf16x8*)(lds + PG8_SA(b, h) + aoff + m * 2048 + k * 1024); } while (0)
#define PG8_LDB(dst, b, h) do { _Pragma("unroll") for (int n = 0; n < 2; ++n) _Pragma("unroll") for (int k = 0; k < 2; ++k) dst[n][k] = *(const PG8_LAS bf16x8*)(lds + PG8_SB(b, h) + boff + n * 2048 + k * 1024); } while (0)
#define PG8_MMA(ai, bj, At, Bt) do { __builtin_amdgcn_s_setprio(1); _Pragma("unroll") for (int m = 0; m < 4; ++m) _Pragma("unroll") for (int n = 0; n < 2; ++n) _Pragma("unroll") for (int k = 0; k < 2; ++k) \
        acc[ai][bj][m][n] = __builtin_amdgcn_mfma_f32_16x16x32_bf16(Bt[n][k], At[m][k], acc[ai][bj][m][n], 0, 0, 0); __builtin_amdgcn_s_setprio(0); } while (0)
#define PG8_WAIT_V(n) asm volatile("s_waitcnt vmcnt(" #n ")" ::: "memory")
#define PG8_WAIT_L(n) asm volatile("s_waitcnt lgkmcnt(" #n ")" ::: "memory")
#define PG8_BAR __builtin_amdgcn_s_barrier()
#define PG8_SCHED __builtin_amdgcn_sched_barrier(0)
    Unit cur, nxt; int ui = 0;
    if (!S.next(0, cur)) return;
    f32x4 acc[2][2][4][2];
#pragma unroll
    for (int a = 0; a < 2; ++a)
#pragma unroll
        for (int b = 0; b < 2; ++b)
#pragma unroll
            for (int m = 0; m < 4; ++m)
#pragma unroll
                for (int n = 0; n < 2; ++n) acc[a][b][m][n] = (f32x4){0.f, 0.f, 0.f, 0.f};
    bf16x8 At[4][2], B0[2][2], B1[2][2];
    const char* cA = (const char*)g.A + (size_t)cur.pm * tstep; const char* cB = (const char*)g.Bt + (size_t)cur.pn * tstep;
    S.a_ready(cur);
    if constexpr (SP2) {
        PG8_STAGE(PG8_SB(0, 0), cB, voffB); PG8_STAGE(PG8_SB(0, 1), cB + hstep, voffB); PG8_STAGE(PG8_SA(0, 0), cA, voffA); PG8_STAGE(PG8_SA(0, 1), cA + hstep, voffA);
        if (wr == 1) PG8_BAR;
        PG8_WAIT_V(2); PG8_BAR;
        PG8_STAGE(PG8_SB(1, 0), cB + kstep, voffB); PG8_STAGE(PG8_SA(1, 0), cA + kstep, voffA); PG8_STAGE(PG8_SB(1, 1), cB + hstep + kstep, voffB);
        PG8_WAIT_V(6); PG8_BAR;
    } else {
        PG8_STAGE(PG8_SB(0, 0), cB, voffB); PG8_STAGE(PG8_SA(0, 0), cA, voffA); PG8_STAGE(PG8_SB(0, 1), cB + hstep, voffB); PG8_STAGE(PG8_SA(0, 1), cA + hstep, voffA);
        if (wr == 1) PG8_BAR;
        PG8_WAIT_V(4); PG8_BAR;
        PG8_STAGE(PG8_SB(1, 0), cB + kstep, voffB); PG8_STAGE(PG8_SA(1, 0), cA + kstep, voffA); PG8_STAGE(PG8_SB(1, 1), cB + hstep + kstep, voffB);
        PG8_WAIT_V(6); PG8_BAR;
    }
    for (;;) {
        const bool has_next = S.next(ui + 1, nxt);
        const char* nA = has_next ? (const char*)g.A + (size_t)nxt.pm * tstep : cA; const char* nB = has_next ? (const char*)g.Bt + (size_t)nxt.pn * tstep : cB;
        for (int t = 0; t < nt; t += 2) {
            const bool last = (t == nt - 2);
            const char* a1 = cA + (size_t)(t + 1) * kstep;
            const char* a2 = last ? nA : cA + (size_t)(t + 2) * kstep; const char* b2 = last ? nB : cB + (size_t)(t + 2) * kstep;
            const char* a3 = a2 + kstep; const char* b3 = b2 + kstep;
            if (last && has_next) S.a_ready(nxt);
            if constexpr (SP2) {
            PG8_LDB(B0, 0, 0); PG8_LDB(B1, 0, 1); PG8_SCHED; PG8_LDA(At, 0, 0); PG8_STAGE(PG8_SA(1, 1), a1 + hstep, voffA);
            PG8_WAIT_V(8); PG8_WAIT_L(0); PG8_BAR; PG8_MMA(0, 0, At, B0); PG8_MMA(0, 1, At, B1); PG8_BAR; PG8_SCHED;
            PG8_LDA(At, 0, 1); PG8_STAGE(PG8_SB(0, 0), b2, voffB); PG8_STAGE(PG8_SB(0, 1), b2 + hstep, voffB); PG8_STAGE(PG8_SA(0, 0), a2, voffA);
            PG8_WAIT_V(8); PG8_WAIT_L(0); PG8_BAR; PG8_MMA(1, 0, At, B0); PG8_MMA(1, 1, At, B1); PG8_BAR; PG8_SCHED;
            PG8_LDB(B0, 1, 0); PG8_LDB(B1, 1, 1); PG8_SCHED; PG8_LDA(At, 1, 0); PG8_STAGE(PG8_SA(0, 1), a2 + hstep, voffA);
            PG8_WAIT_V(8); PG8_WAIT_L(0); PG8_BAR; PG8_MMA(0, 0, At, B0); PG8_MMA(0, 1, At, B1); PG8_BAR; PG8_SCHED;
            PG8_LDA(At, 1, 1); PG8_STAGE(PG8_SB(1, 0), b3, voffB); PG8_STAGE(PG8_SB(1, 1), b3 + hstep, voffB); PG8_STAGE(PG8_SA(1, 0), a3, voffA);
            PG8_WAIT_V(8); PG8_WAIT_L(0); PG8_BAR; PG8_MMA(1, 0, At, B0); PG8_MMA(1, 1, At, B1); PG8_BAR; PG8_SCHED;
            } else {
            PG8_LDB(B0, 0, 0); PG8_SCHED; PG8_LDA(At, 0, 0); PG8_STAGE(PG8_SA(1, 1), a1 + hstep, voffA);
            PG8_WAIT_L(8); PG8_BAR; PG8_WAIT_L(0); PG8_MMA(0, 0, At, B0); PG8_BAR; PG8_SCHED;
            PG8_LDB(B1, 0, 1); PG8_STAGE(PG8_SB(0, 0), b2, voffB);
            PG8_BAR; PG8_WAIT_L(0); PG8_MMA(0, 1, At, B1); PG8_BAR;
            PG8_LDA(At, 0, 1); PG8_STAGE(PG8_SA(0, 0), a2, voffA);
            PG8_BAR; PG8_WAIT_L(0); PG8_MMA(1, 0, At, B0); PG8_BAR; PG8_SCHED;
            PG8_STAGE(PG8_SB(0, 1), b2 + hstep, voffB);
            PG8_WAIT_V(6); PG8_BAR; PG8_MMA(1, 1, At, B1); PG8_BAR;
            PG8_LDB(B0, 1, 0); PG8_SCHED; PG8_LDA(At, 1, 0); PG8_STAGE(PG8_SA(0, 1), a2 + hstep, voffA);
            PG8_WAIT_L(8); PG8_BAR; PG8_WAIT_L(0); PG8_MMA(0, 0, At, B0); PG8_BAR; PG8_SCHED;
            PG8_LDB(B1, 1, 1); PG8_STAGE(PG8_SB(1, 0), b3, voffB);
            PG8_BAR; PG8_WAIT_L(0); PG8_MMA(0, 1, At, B1); PG8_BAR;
            PG8_LDA(At, 1, 1); PG8_STAGE(PG8_SA(1, 0), a3, voffA);
            PG8_BAR; PG8_WAIT_L(0); PG8_MMA(1, 0, At, B0); PG8_BAR; PG8_SCHED;
            PG8_STAGE(PG8_SB(1, 1), b3 + hstep, voffB);
            PG8_WAIT_V(6); PG8_BAR; PG8_MMA(1, 1, At, B1); PG8_BAR;
            }
        }
        if constexpr (ALIGN_EPI) { if (wr == 0) PG8_BAR; }
        if constexpr (!Epi::AFTER_DRAIN) { E(acc, cur, wr, wc, fr, fq); S.done(cur); }
        if (!has_next) break;
#pragma unroll
        for (int a = 0; a < 2; ++a)
#pragma unroll
            for (int b = 0; b < 2; ++b)
#pragma unroll
                for (int m = 0; m < 4; ++m)
#pragma unroll
                    for (int n = 0; n < 2; ++n) acc[a][b][m][n] = (f32x4){0.f, 0.f, 0.f, 0.f};
        cur = nxt; cA = nA; cB = nB; ++ui;
        if constexpr (ALIGN_EPI) { if (wr == 1) PG8_BAR; }
    }
    PG8_WAIT_V(0);
    if constexpr (!ALIGN_EPI) { if (wr == 0) PG8_BAR; }
    PG8_BAR;
    if constexpr (Epi::AFTER_DRAIN) { E.fused(acc, cur, wr, wc, fr, fq, lds, wid, lane); S.done(cur); }
#undef PG8_SA
#undef PG8_SB
#undef PG8_STAGE
#undef PG8_LDA
#undef PG8_LDB
#undef PG8_MMA
#undef PG8_WAIT_V
#undef PG8_WAIT_L
#undef PG8_BAR
#undef PG8_SCHED
}
}
#define XB_TMO      128
#define XB_XCNT(j)  (256  + 64 * (j))
#define XB_XSUB(j)  (1280 + 64 * (j))
#define XB_XGEN(j)  (2304 + 64 * (j))
#define XB_TOP      3328
#define XB_TOPGEN   3392
#define XCD_BAR_WORDS 3456
#define XB_SPIN_CAP (1u << 18)

__device__ __forceinline__ unsigned xb_ld(unsigned* p)              { return __hip_atomic_load(p, __ATOMIC_RELAXED, __HIP_MEMORY_SCOPE_AGENT); }
__device__ __forceinline__ unsigned xb_add(unsigned* p, unsigned v) { return __hip_atomic_fetch_add(p, v, __ATOMIC_RELAXED, __HIP_MEMORY_SCOPE_AGENT); }
__device__ __forceinline__ unsigned xb_xcc_id() { return (unsigned)__builtin_amdgcn_s_getreg((3 << 11) | 20) & 0xFu; }
#define XB_SPIN(cond, bar) do { unsigned _sp = 0; while (cond) { __builtin_amdgcn_s_sleep(1); \
    if ((++_sp & 255u) == 0u) { if (xb_ld(&(bar)[XB_TMO])) break; if (_sp > XB_SPIN_CAP) { atomicAdd(&(bar)[XB_TMO], 1u); break; } } } } while (0)

struct XcdBarrier {
    unsigned* bar; unsigned x;
    volatile LAS unsigned* st;
};

__device__ __forceinline__ XcdBarrier xcd_barrier_post(unsigned* bar, volatile LAS unsigned* st) {
    XcdBarrier b; b.bar = bar; b.x = xb_xcc_id(); b.st = st;
    if (threadIdx.x == 0) (void)xb_add(&bar[XB_XCNT(b.x)], 1u);
    return b;
}
__device__ __forceinline__ void xcd_barrier_complete(unsigned* bar, unsigned x, unsigned& nloc, unsigned& nx) {
    const unsigned G = gridDim.x * gridDim.y * gridDim.z;
    unsigned sum, cnt, mine, sp = 0u;
    for (;;) {
        sum = 0u; cnt = 0u; mine = 0u;
#pragma unroll
        for (unsigned j = 0; j < 16; ++j) { const unsigned c = xb_ld(&bar[XB_XCNT(j)]); sum += c; cnt += (c > 0u) ? 1u : 0u; mine = (j == x) ? c : mine; }
        if (sum == G) break;
        __builtin_amdgcn_s_sleep(1);
        if ((++sp & 255u) == 0u) { if (xb_ld(&bar[XB_TMO])) break; if (sp > XB_SPIN_CAP) { atomicAdd(&bar[XB_TMO], 1u); break; } }
    }
    nloc = mine > 0u ? mine : 1u; nx = cnt > 0u ? cnt : 1u;
}

__device__ __forceinline__ void xcd_barrier(const XcdBarrier& b) {
    asm volatile("s_waitcnt vmcnt(0)" ::: "memory");
    __syncthreads();
    if (threadIdx.x == 0) {
        unsigned* bar = b.bar;
        __builtin_amdgcn_s_waitcnt(0);
        unsigned nloc = b.st[0], nx = b.st[1];
        if (nloc == 0u) { xcd_barrier_complete(bar, b.x, nloc, nx); b.st[0] = nloc; b.st[1] = nx; }
        const unsigned old = xb_add(&bar[XB_XSUB(b.x)], 1u);
        const unsigned gen = old / nloc;
        if (old + 1u == (gen + 1u) * nloc) {
            __builtin_amdgcn_fence(__ATOMIC_RELEASE, "agent");
            asm volatile("s_waitcnt vmcnt(0)" ::: "memory");
            const unsigned og = xb_add(&bar[XB_TOP], 1u);
            const unsigned tg = og / nx;
            if (og + 1u == (tg + 1u) * nx) xb_add(&bar[XB_TOPGEN], 1u);
            else XB_SPIN(xb_ld(&bar[XB_TOPGEN]) == tg, bar);
            __builtin_amdgcn_fence(__ATOMIC_ACQUIRE, "agent");
            xb_add(&bar[XB_XGEN(b.x)], 1u);
            asm volatile("s_waitcnt vmcnt(0)" ::: "memory");
        } else {
            XB_SPIN(xb_ld(&bar[XB_XGEN(b.x)]) == gen, bar);
            __builtin_amdgcn_fence(__ATOMIC_ACQUIRE, "agent");
            asm volatile("s_waitcnt vmcnt(0)" ::: "memory");
        }
    }
    __syncthreads();
}

__device__ __forceinline__ void tr_item(const float* __restrict__ W, int N, const float* __restrict__ g, bf16* __restrict__ WT, int ldk, int item, int lane) {
    const int nblk = N >> 6, kb = item / nblk, nb = item - kb * nblk, k0 = kb << 6, n = (nb << 6) + lane;
    const float* src = W + (size_t)k0 * N + n;
    float v[64];
#pragma unroll
    for (int i = 0; i < 64; ++i) v[i] = src[(size_t)i * N];
    if (g) {
#pragma unroll
        for (int i = 0; i < 64; ++i) v[i] *= g[k0 + i];
    }
    v4u* dst = (v4u*)(WT + (size_t)n * ldk + k0);
#pragma unroll
    for (int j = 0; j < 8; ++j) { v4u o; o.x = pk2(v[8 * j], v[8 * j + 1]); o.y = pk2(v[8 * j + 2], v[8 * j + 3]); o.z = pk2(v[8 * j + 4], v[8 * j + 5]); o.w = pk2(v[8 * j + 6], v[8 * j + 7]); dst[j] = o; }
}
__device__ __forceinline__ void fold_item(const float* __restrict__ pw, const float* __restrict__ scale, const float* __restrict__ wout, bf16* __restrict__ WT, LAS float* scr, int item, int lane) {
    const int kb = item >> 4, nb = item & 15, kp0 = kb << 5, g = kp0 >> 7, c0 = kp0 & 127, n = (nb << 6) + lane;
    const f32x4* psrc = (const f32x4*)(pw + (size_t)(g * 128 + c0) * 128);
#pragma unroll
    for (int i = 0; i < 16; ++i) *(LAS f32x4*)(scr + (i * 64 + lane) * 4) = psrc[i * 64 + lane];
    LDS_WAIT(); asm volatile("" ::: "memory");
    const float* wsrc = wout + (size_t)(512 + g * 128) * 1024 + n;
    const float* ssrc = scale + g * 128;
    float acc[32];
#pragma unroll
    for (int i = 0; i < 32; ++i) acc[i] = 0.f;
    for (int d4 = 0; d4 < 32; ++d4) {
        const f32x4 s4 = *(const f32x4*)(ssrc + 4 * d4);
        const float v0 = wsrc[(size_t)(4 * d4 + 0) * 1024] * s4[0], v1 = wsrc[(size_t)(4 * d4 + 1) * 1024] * s4[1], v2 = wsrc[(size_t)(4 * d4 + 2) * 1024] * s4[2], v3 = wsrc[(size_t)(4 * d4 + 3) * 1024] * s4[3];
#pragma unroll
        for (int i = 0; i < 32; ++i) { const f32x4 p = *(const LAS f32x4*)(scr + i * 128 + 4 * d4); acc[i] += (p[0] * v0 + p[1] * v1) + (p[2] * v2 + p[3] * v3); }
    }
    v4u* dst = (v4u*)(WT + (size_t)n * 1024 + 512 + kp0);
#pragma unroll
    for (int j = 0; j < 4; ++j) { v4u o; o.x = pk2(acc[8 * j], acc[8 * j + 1]); o.y = pk2(acc[8 * j + 2], acc[8 * j + 3]); o.z = pk2(acc[8 * j + 4], acc[8 * j + 5]); o.w = pk2(acc[8 * j + 6], acc[8 * j + 7]); dst[j] = o; }
    LDS_WAIT(); asm volatile("" ::: "memory");
}
__device__ __forceinline__ void xrow_item(const float* __restrict__ xrow, bf16* __restrict__ orow, float* __restrict__ ssrow, int nss, float* __restrict__ copy, int lane) {
    const f32x4* xr = (const f32x4*)xrow + lane;
    f32x4 v[4]; float s = 0.f;
#pragma unroll
    for (int j = 0; j < 4; ++j) { v[j] = xr[64 * j]; s += (v[j][0] * v[j][0] + v[j][1] * v[j][1]) + (v[j][2] * v[j][2] + v[j][3] * v[j][3]); }
    s = wave_sum(s);
    v2u* o8 = (v2u*)orow + lane;
#pragma unroll
    for (int j = 0; j < 4; ++j) { v2u o; o.x = pk2(v[j][0], v[j][1]); o.y = pk2(v[j][2], v[j][3]); o8[64 * j] = o; }
    if (copy) {
#pragma unroll
        for (int j = 0; j < 4; ++j) ((f32x4*)copy + lane)[64 * j] = v[j];
    }
    if (lane < nss) ssrow[lane] = (lane == 0) ? s : 0.f;
}
__device__ __forceinline__ void cvt_item(const float* __restrict__ src, bf16* __restrict__ dst, int item, int lane) {
    const size_t idx = (size_t)item * 512 + lane * 8;
    const f32x4 a = *(const f32x4*)(src + idx), b = *(const f32x4*)(src + idx + 4);
    v4u o; o.x = pk2(a[0], a[1]); o.y = pk2(a[2], a[3]); o.z = pk2(b[0], b[1]); o.w = pk2(b[2], b[3]);
    *(v4u*)(dst + idx) = o;
}
__device__ __forceinline__ void final_row(const float* __restrict__ hrow, float rstd, const float* __restrict__ gf, float* __restrict__ yrow, int lane) {
#pragma unroll
    for (int j = 0; j < 4; ++j) { const f32x4 v = ((const f32x4*)hrow + lane)[64 * j], gg = ((const f32x4*)gf + lane)[64 * j]; ((f32x4*)yrow + lane)[64 * j] = v * rstd * gg; }
}

__device__ __forceinline__ int crow(int i, int hi) { return (i & 3) + 8 * (i >> 2) + 4 * hi; }
__device__ __forceinline__ s16x4 vtr(LAS unsigned char* p) { typedef short v4i16_t __attribute__((ext_vector_type(4))); return __builtin_bit_cast(s16x4, __builtin_amdgcn_ds_read_tr16_b64_v4i16((LAS v4i16_t*)p)); }
__device__ __forceinline__ unsigned cvtpk(float lo, float hi) { typedef float f2 __attribute__((ext_vector_type(2))); typedef __bf16 b2 __attribute__((ext_vector_type(2))); f2 v = {lo, hi}; b2 b = __builtin_convertvector(v, b2); return __builtin_bit_cast(unsigned, b); }
__device__ __forceinline__ void attn_tile(const bf16* __restrict__ X  , int h, int dsh, int r, int c0, LAS unsigned char* vst  ,
                                          bf16* __restrict__ OP  , float* __restrict__ LS  , int lane) {
    const int r32 = lane & 31, hi = lane >> 5;
    const int nskip = (c0 < 128) ? ((128 - c0) >> 5) : 0;
    const float NEG = -1e30f;
    bf16x8 qf[4];
    { const bf16* qp = X + (size_t)(((c0 + r32) << dsh) + r) * 2048 + h * 64 + 8 * hi;
#pragma unroll
      for (int ds = 0; ds < 4; ++ds) qf[ds] = *(const bf16x8*)(qp + 16 * ds); }
    f32x16 s[5];
#pragma unroll
    for (int blk = 0; blk < 5; ++blk) {
        if (blk >= nskip) {
            const int kc = c0 - 128 + 32 * blk + r32;
            const bf16* kp = X + (size_t)((kc << dsh) + r) * 2048 + 512 + h * 64 + 8 * hi;
            f32x16 a;
#pragma unroll
            for (int i = 0; i < 16; ++i) a[i] = 0.f;
#pragma unroll
            for (int ds = 0; ds < 4; ++ds) a = __builtin_amdgcn_mfma_f32_32x32x16_bf16(*(const bf16x8*)(kp + 16 * ds), qf[ds], a, 0, 0, 0);
            s[blk] = a;
        } else {
#pragma unroll
            for (int i = 0; i < 16; ++i) s[blk][i] = NEG;
        }
    }
#pragma unroll
    for (int i = 0; i < 16; ++i) { const int kr = crow(i, hi); if (kr < r32) s[0][i] = NEG; if (kr > r32) s[4][i] = NEG; }
    float m = s[4][0];
#pragma unroll
    for (int blk = 0; blk < 5; ++blk)
#pragma unroll
        for (int i = 0; i < 16; ++i) m = fmaxf(m, s[blk][i]);
    m = fmaxf(m, __shfl_xor(m, 32));
    float l = 0.f;
#pragma unroll
    for (int blk = 0; blk < 5; ++blk)
#pragma unroll
        for (int i = 0; i < 16; ++i) { const float p = __builtin_amdgcn_exp2f(s[blk][i] - m); s[blk][i] = p; l += p; }
    l += __shfl_xor(l, 32);
    f32x16 o[2];
#pragma unroll
    for (int i = 0; i < 16; ++i) { o[0][i] = 0.f; o[1][i] = 0.f; }
    const int vrow8 = (lane >> 2) & 7, vc = (lane & 3) + 4 * (lane >> 5);
    const int vb = (4 * hi + ((lane & 15) >> 2)) * 64 + ((lane >> 4) & 1) * 32 + (lane & 3) * 8;
#pragma unroll
    for (int blk = 0; blk < 5; ++blk) {
        if (blk >= nskip) {
            LAS unsigned char* buf = vst + (blk & 1) * 4096;
            const int kb = c0 - 128 + 32 * blk;
            v4u vv[4];
#pragma unroll
            for (int i = 0; i < 4; ++i) { const int kc = kb + 8 * i + vrow8; vv[i] = *(const v4u*)(X + (size_t)((kc << dsh) + r) * 2048 + 1024 + h * 64 + 8 * vc); }
#pragma unroll
            for (int i = 0; i < 4; ++i) *(LAS v4u*)(buf + i * 1024 + lane * 16) = vv[i];
            LDS_WAIT(); asm volatile("" ::: "memory");
#pragma unroll
            for (int s2 = 0; s2 < 2; ++s2) {
                v4u pw; pw.x = cvtpk(s[blk][8 * s2 + 0], s[blk][8 * s2 + 1]); pw.y = cvtpk(s[blk][8 * s2 + 2], s[blk][8 * s2 + 3]); pw.z = cvtpk(s[blk][8 * s2 + 4], s[blk][8 * s2 + 5]); pw.w = cvtpk(s[blk][8 * s2 + 6], s[blk][8 * s2 + 7]);
                const bf16x8 pf = __builtin_bit_cast(bf16x8, pw);
#pragma unroll
                for (int d0 = 0; d0 < 2; ++d0) {
                    const s16x4 a = vtr(buf + vb + (2 * s2) * 1024 + d0 * 512), b = vtr(buf + vb + (2 * s2 + 1) * 1024 + d0 * 512);
                    const bf16x8 vf = (bf16x8){a[0], a[1], a[2], a[3], b[0], b[1], b[2], b[3]};
                    o[d0] = __builtin_amdgcn_mfma_f32_32x32x16_bf16(vf, pf, o[d0], 0, 0, 0);
                }
            }
            LDS_WAIT(); asm volatile("" ::: "memory");
        }
    }
    const float inv = 1.0f / l;
    const int tq = ((c0 + r32) << dsh) + r;
    bf16* op = OP + (size_t)tq * 512 + h * 64 + 4 * hi;
#pragma unroll
    for (int d0 = 0; d0 < 2; ++d0)
#pragma unroll
        for (int gq = 0; gq < 4; ++gq) { v2u w; w.x = cvtpk(o[d0][4 * gq] * inv, o[d0][4 * gq + 1] * inv); w.y = cvtpk(o[d0][4 * gq + 2] * inv, o[d0][4 * gq + 3] * inv); *(v2u*)(op + 32 * d0 + 8 * gq) = w; }
    if (hi == 0) LS[(size_t)tq * 8 + h] = m + __builtin_amdgcn_logf(l);
}
__device__ __forceinline__ void merge_z_unit(const bf16* __restrict__ QKVU, const bf16* __restrict__ OPART, const float* __restrict__ LSE, bf16* __restrict__ AO, int b, int h, int T0, int tid) {
    const int ch = tid & 7, tg = tid >> 3;
    const int w = 2 << (h >> 1);
    const size_t rowb = (size_t)b * SEQ;
    const bf16* ub = QKVU + rowb * 2048 + 1536 + h * 64 + 8 * ch;
    float sacc[8];
#pragma unroll
    for (int e = 0; e < 8; ++e) sacc[e] = 0.f;
    const int tfirst = T0 + 8 * tg;
    for (int j = 1; j < w; ++j) { const int tt = tfirst - j; if (tt >= 0) { const v4u x = *(const v4u*)(ub + (size_t)tt * 2048);
        sacc[0] += bflo(x.x); sacc[1] += bfhi(x.x); sacc[2] += bflo(x.y); sacc[3] += bfhi(x.y); sacc[4] += bflo(x.z); sacc[5] += bfhi(x.z); sacc[6] += bflo(x.w); sacc[7] += bfhi(x.w); } }
#pragma unroll 1
    for (int i = 0; i < 8; ++i) {
        const int t = tfirst + i; const size_t row = rowb + t;
        const float l0 = LSE[((size_t)0 * M + row) * 8 + h], l1 = LSE[((size_t)1 * M + row) * 8 + h], l2 = LSE[((size_t)2 * M + row) * 8 + h];
        const float mx = fmaxf(l0, fmaxf(l1, l2));
        float w0 = __builtin_amdgcn_exp2f(l0 - mx), w1 = __builtin_amdgcn_exp2f(l1 - mx), w2 = __builtin_amdgcn_exp2f(l2 - mx);
        const float inv = 1.0f / (w0 + w1 + w2); w0 *= inv; w1 *= inv; w2 *= inv;
        const v4u a0 = *(const v4u*)(OPART + ((size_t)0 * M + row) * 512 + h * 64 + 8 * ch), a1 = *(const v4u*)(OPART + ((size_t)1 * M + row) * 512 + h * 64 + 8 * ch), a2 = *(const v4u*)(OPART + ((size_t)2 * M + row) * 512 + h * 64 + 8 * ch);
        v4u oa;
        oa.x = pk2(w0 * bflo(a0.x) + w1 * bflo(a1.x) + w2 * bflo(a2.x), w0 * bfhi(a0.x) + w1 * bfhi(a1.x) + w2 * bfhi(a2.x));
        oa.y = pk2(w0 * bflo(a0.y) + w1 * bflo(a1.y) + w2 * bflo(a2.y), w0 * bfhi(a0.y) + w1 * bfhi(a1.y) + w2 * bfhi(a2.y));
        oa.z = pk2(w0 * bflo(a0.z) + w1 * bflo(a1.z) + w2 * bflo(a2.z), w0 * bfhi(a0.z) + w1 * bfhi(a1.z) + w2 * bfhi(a2.z));
        oa.w = pk2(w0 * bflo(a0.w) + w1 * bflo(a1.w) + w2 * bflo(a2.w), w0 * bfhi(a0.w) + w1 * bfhi(a1.w) + w2 * bfhi(a2.w));
        *(v4u*)(AO + row * 1024 + h * 64 + 8 * ch) = oa;
        const v4u x = *(const v4u*)(ub + (size_t)t * 2048);
        float u8[8] = {bflo(x.x), bfhi(x.x), bflo(x.y), bfhi(x.y), bflo(x.z), bfhi(x.z), bflo(x.w), bfhi(x.w)};
#pragma unroll
        for (int e = 0; e < 8; ++e) sacc[e] += u8[e];
        const float rc = 1.0f / (float)((t + 1 < w) ? (t + 1) : w);
        v4u oz; oz.x = pk2(sacc[0] * rc - u8[0], sacc[1] * rc - u8[1]); oz.y = pk2(sacc[2] * rc - u8[2], sacc[3] * rc - u8[3]); oz.z = pk2(sacc[4] * rc - u8[4], sacc[5] * rc - u8[5]); oz.w = pk2(sacc[6] * rc - u8[6], sacc[7] * rc - u8[7]);
        *(v4u*)(AO + row * 1024 + 512 + h * 64 + 8 * ch) = oz;
        const int td = t + 1 - w;
        if (td >= 0) { const v4u y = *(const v4u*)(ub + (size_t)td * 2048);
            sacc[0] -= bflo(y.x); sacc[1] -= bfhi(y.x); sacc[2] -= bflo(y.y); sacc[3] -= bfhi(y.y); sacc[4] -= bflo(y.z); sacc[5] -= bfhi(y.z); sacc[6] -= bflo(y.w); sacc[7] -= bfhi(y.w); }
    }
}

__device__ __forceinline__ void sample_attn_unit(const float* __restrict__ ckv  , const float* __restrict__ spool  ,
                                                 const float* __restrict__ QS, const float* __restrict__ kvnew  , float* __restrict__ psout  ,
                                                 bf16* __restrict__ AOS, int bs, int h, LAS float* red, int wave, int lane, int tid) {
    const int ks = lane >> 4, d4 = lane & 15;
    const f32x4 q4 = *(const f32x4*)(QS + bs * 512 + h * 64 + 4 * d4);
    const float* cb = ckv + (size_t)bs * 2048 * 1024 + h * 64 + 4 * d4;
    const float* nk = kvnew + bs * 1024 + h * 64 + 4 * d4;
    float sc[13]; f32x4 vv[13];
#pragma unroll
    for (int i = 0; i < 13; ++i) {
        const int idx = wave * 52 + i * 4 + ks; const bool valid = idx < 387;
        const int g = (idx >= 258) ? 2 : ((idx >= 129) ? 1 : 0), j = idx - g * 129;
        const float* kp = (valid && j > 0) ? (cb + (size_t)(2048 - (j << (2 * g))) * 1024) : nk;
        const f32x4 k4 = *(const f32x4*)kp; vv[i] = *(const f32x4*)(kp + 512);
        float d = (q4[0] * k4[0] + q4[1] * k4[1]) + (q4[2] * k4[2] + q4[3] * k4[3]);
        d += __shfl_xor(d, 1); d += __shfl_xor(d, 2); d += __shfl_xor(d, 4); d += __shfl_xor(d, 8);
        sc[i] = valid ? d : -1e30f;
    }
    float m = sc[0];
#pragma unroll
    for (int i = 1; i < 13; ++i) m = fmaxf(m, sc[i]);
    m = fmaxf(m, __shfl_xor(m, 16)); m = fmaxf(m, __shfl_xor(m, 32));
    float l = 0.f; f32x4 o = {0.f, 0.f, 0.f, 0.f};
#pragma unroll
    for (int i = 0; i < 13; ++i) { const float p = __builtin_amdgcn_exp2f(sc[i] - m); l += p; o += vv[i] * p; }
    l += __shfl_xor(l, 16); l += __shfl_xor(l, 32);
#pragma unroll
    for (int e = 0; e < 4; ++e) { o[e] += __shfl_xor(o[e], 16); o[e] += __shfl_xor(o[e], 32); }
    if (ks == 0) *(LAS f32x4*)(red + wave * 68 + 4 * d4) = o;
    if (lane == 0) { red[wave * 68 + 64] = m; red[wave * 68 + 65] = l; }
    __syncthreads();
    if (tid < 64) {
        float mm = red[64];
#pragma unroll
        for (int w = 1; w < 8; ++w) mm = fmaxf(mm, red[w * 68 + 64]);
        float L = 0.f, O = 0.f;
#pragma unroll
        for (int w = 0; w < 8; ++w) { const float f = __builtin_amdgcn_exp2f(red[w * 68 + 64] - mm); L += red[w * 68 + 65] * f; O += red[w * 68 + tid] * f; }
        AOS[bs * 1024 + h * 64 + tid] = (bf16)f2bf(O / L);
    } else if (tid < 128) {
        const int col = h * 64 + (tid - 64); const int w = 2 << (h >> 1);
        const float un = psout[(size_t)(bs * 15 + 14) * 512 + col];
        float s = un;
        for (int j = 1; j < w; ++j) s += spool[(size_t)(bs * 15 + (15 - j)) * 512 + col];
        AOS[bs * 1024 + 512 + col] = (bf16)f2bf(s / (float)w - un);
    } else if (tid < 192) {
        const int col = h * 64 + (tid - 128);
#pragma unroll
        for (int i = 0; i < 14; ++i) psout[(size_t)(bs * 15 + i) * 512 + col] = spool[(size_t)(bs * 15 + i + 1) * 512 + col];
    }
    __syncthreads();
}
template <int K> __device__ __forceinline__ f32x4 sg_tile(const bf16* __restrict__ A, const bf16* __restrict__ Bt, int n0, LAS float* red, int wave, int lane, int tid) {
    constexpr int KW = K / 8;
    f32x4 acc[2][4];
#pragma unroll
    for (int a = 0; a < 2; ++a)
#pragma unroll
        for (int c = 0; c < 4; ++c) acc[a][c] = (f32x4){0.f, 0.f, 0.f, 0.f};
    const int r16 = lane & 15, kq = lane >> 4;
    const bf16* ap = A + (size_t)r16 * K + wave * KW + 8 * kq;
    const bf16* bp = Bt + (size_t)(n0 + r16) * K + wave * KW + 8 * kq;
#pragma unroll 2
    for (int k = 0; k < KW; k += 32) {
        const bf16x8 a0 = *(const bf16x8*)(ap + k), a1 = *(const bf16x8*)(ap + (size_t)16 * K + k);
#pragma unroll
        for (int c = 0; c < 4; ++c) { const bf16x8 bb = *(const bf16x8*)(bp + (size_t)c * 16 * K + k);
            acc[0][c] = __builtin_amdgcn_mfma_f32_16x16x32_bf16(a0, bb, acc[0][c], 0, 0, 0); acc[1][c] = __builtin_amdgcn_mfma_f32_16x16x32_bf16(a1, bb, acc[1][c], 0, 0, 0); }
    }
#pragma unroll
    for (int a = 0; a < 2; ++a)
#pragma unroll
        for (int c = 0; c < 4; ++c)
#pragma unroll
            for (int i = 0; i < 4; ++i) red[(wave * 32 + 16 * a + 4 * kq + i) * 64 + 16 * c + r16] = acc[a][c][i];
    __syncthreads();
    const int row = tid >> 4, c4 = (tid & 15) * 4;
    f32x4 sum = (f32x4){0.f, 0.f, 0.f, 0.f};
#pragma unroll
    for (int w = 0; w < 8; ++w) sum += *(const LAS f32x4*)(red + (w * 32 + row) * 64 + c4);
    return sum;
}
__device__ __forceinline__ float srstd(const float* __restrict__ sss, int row) {
    const f32x4* p = (const f32x4*)(sss + row * 16); const f32x4 a = p[0] + p[1] + p[2] + p[3];
    return __builtin_amdgcn_rsqf(((a[0] + a[1]) + (a[2] + a[3])) * (1.0f / 1024.0f) + 1e-6f);
}
__device__ __forceinline__ void sss_put(float* __restrict__ sss, int row, int task, const f32x4 o, int tid) {
    float q = (o[0] * o[0] + o[1] * o[1]) + (o[2] * o[2] + o[3] * o[3]);
    q += __shfl_xor(q, 1); q += __shfl_xor(q, 2); q += __shfl_xor(q, 4); q += __shfl_xor(q, 8);
    if ((tid & 15) == 0) sss[row * 16 + task] = q;
}

struct Args { const float* in[18]; float* out; unsigned char* ws; int ph_lo, ph_hi; };
#define IN(k) (lo <= (k) && (k) < hi)
#define SEAM(k) do { if (IN((k) + 1)) { bar.bar = (unsigned*)(KWS() + WS_CTL) + CW_BAR; xcd_barrier(bar); } } while (0)
#define PH_TID() int lane = (int)__builtin_amdgcn_mbcnt_hi(~0u, __builtin_amdgcn_mbcnt_lo(~0u, 0u)); asm volatile("" : "+v"(lane)); const int tid = wave * 64 + lane;
template <int L> __device__ __forceinline__ void layer_phases(LAS unsigned char* lds, const int lo, const int hi, const int G, const int bx, const int wave, XcdBarrier& bar) {
    constexpr int l = L;
    LAS float* red0 = (LAS float*)(lds + RING_OFF); LAS float* red1 = (LAS float*)(lds + RING_OFF + 65536);
        const int pb = 1 + 6 * l;
        if (IN(pb + 0)) {
            PH_TID();
            if (bx < DIN / 64) {
                unsigned char* ws = KWS(); float* outp = KOUT();
                const bf16* hsbx = (const bf16*)(ws + WS_SMP + ((l & 1) ? SMP_HSB1 : SMP_HSB0));
                for (int t = bx; t < DIN / 64; t += G) {
                    const f32x4 v = sg_tile<D>(hsbx, (const bf16*)(ws + WS_W + l * W_LAYER + W_IN), t * 64, red0, wave, lane, tid) * srstd((const float*)(ws + WS_SMP + SMP_SSS), tid >> 4);
                    const int row = tid >> 4, col = t * 64 + (tid & 15) * 4;
                    if (col < 512) *(f32x4*)((float*)(ws + WS_SMP + SMP_QS) + row * 512 + col) = v * QSCALE;
                    else if (col < 1536) *(f32x4*)(outp + O_KVS + (size_t)l * SB * 1024 + row * 1024 + (col - 512)) = v;
                    else *(f32x4*)(outp + O_PS + (size_t)l * SB * PBUF * DP + (size_t)(row * 15 + 14) * 512 + (col - 1536)) = v;
                    __syncthreads();
                }
            }
            unsigned char* ws = KWS();
            pg8::Gemm g{(const bf16*)(ws + ((l & 1) ? WS_HB1 : WS_HB0)), (const bf16*)(ws + WS_W + l * W_LAYER + W_IN), M, DIN, D}; pg8::StaticOrder S; S.init(M, DIN, G, bx);
            pg8::EpiProj E{l};
            pg8::gemm_phase<pg8::EpiProj, pg8::StaticOrder, true, true>(lds + RING_OFF, g, S, E, wave);
            SEAM(pb + 0);
        }
        if (IN(pb + 1)) {
            PH_TID();
            { unsigned char* ws = KWS(); float* outp = KOUT();
              const float* cache_kv = KIN(2) + (size_t)l * SB * 2048 * 1024; const float* state_pool = KIN(3) + (size_t)l * SB * PBUF * DP;
              for (int su = bx; su < SB * 8; su += G)
                sample_attn_unit(cache_kv, state_pool, (const float*)(ws + WS_SMP + SMP_QS), outp + O_KVS + (size_t)l * SB * 1024, outp + O_PS + (size_t)l * SB * PBUF * DP, (bf16*)(ws + WS_SMP + SMP_AOS), su >> 3, su & 7, red0, wave, lane, tid); }
            { unsigned char* ws = KWS();
              const bf16* QKVU = (const bf16*)(ws + WS_QKVU); bf16* OPART = (bf16*)(ws + WS_OPART); float* LSE = (float*)(ws + WS_LSE);
              for (int uid = bx; uid < 256; uid += G) {
                const int h = uid & 7, bc = uid >> 3, b = bc >> 4, T0 = (bc & 15) * 512;
                const bf16* X = QKVU + (size_t)b * SEQ * 2048;
                LAS unsigned char* vst = lds + RING_OFF + 8192 + wave * 8192;
                for (int tile = wave; tile < 48; tile += 8) {
                    const int gp = tile >> 4, idx = tile & 15;
                    int dsh, r, c0;
                    if (gp == 0) { dsh = 0; r = 0; c0 = T0 + 32 * idx; }
                    else if (gp == 1) { dsh = 2; r = idx & 3; c0 = (T0 >> 2) + 32 * (idx >> 2); }
                    else { dsh = 4; r = idx; c0 = T0 >> 4; }
                    attn_tile(X, h, dsh, r, c0, vst, OPART + ((size_t)gp * M + (size_t)b * SEQ) * 512, LSE + ((size_t)gp * M + (size_t)b * SEQ) * 8, lane);
                }
                VM_WAIT(); __syncthreads();
                merge_z_unit(QKVU, OPART, LSE, (bf16*)(ws + WS_AO), b, h, T0, tid);
              } }
            SEAM(pb + 1);
        }
        if (IN(pb + 2)) {
            PH_TID();
            if (bx < D / 64) {
                unsigned char* ws = KWS();
                float* HS = (float*)(ws + WS_SMP + SMP_HS); bf16* hsbx = (bf16*)(ws + WS_SMP + ((l & 1) ? SMP_HSB1 : SMP_HSB0));
                for (int t = bx; t < D / 64; t += G) {
                    const f32x4 s = sg_tile<D>((const bf16*)(ws + WS_SMP + SMP_AOS), (const bf16*)(ws + WS_W + l * W_LAYER + W_OUT), t * 64, red0, wave, lane, tid);
                    const int row = tid >> 4, col = t * 64 + (tid & 15) * 4;
                    const f32x4 o = *(const f32x4*)(HS + row * D + col) + s;
                    *(f32x4*)(HS + row * D + col) = o; v2u w; w.x = pk2(o[0], o[1]); w.y = pk2(o[2], o[3]); *(v2u*)(hsbx + row * D + col) = w;
                    sss_put((float*)(ws + WS_SMP + SMP_SSS) + 512, row, t, o, tid);
                    __syncthreads();
                }
            }
            unsigned char* ws = KWS();
            pg8::Gemm g{(const bf16*)(ws + WS_AO), (const bf16*)(ws + WS_W + l * W_LAYER + W_OUT), M, D, D}; pg8::StaticOrder S; S.init(M, D, G, bx);
            pg8::EpiRes E{l, 0};
            pg8::gemm_phase<pg8::EpiRes, pg8::StaticOrder, false, true>(lds + RING_OFF, g, S, E, wave);
            SEAM(pb + 2);
        }
        if (IN(pb + 3)) {
            PH_TID();
            if (bx < DFF / 64) {
                unsigned char* ws = KWS();
                bf16* ACTS = (bf16*)(ws + WS_SMP + SMP_ACTS);
                for (int t = bx; t < DFF / 64; t += G) {
                    const f32x4 s = sg_tile<D>((const bf16*)(ws + WS_SMP + ((l & 1) ? SMP_HSB1 : SMP_HSB0)), (const bf16*)(ws + WS_W + l * W_LAYER + W_UP), t * 64, red0, wave, lane, tid) * srstd((const float*)(ws + WS_SMP + SMP_SSS) + 512, tid >> 4);
                    const int row = tid >> 4, col = t * 64 + (tid & 15) * 4;
                    const float a0 = fmaxf(s[0], 0.f), a1 = fmaxf(s[1], 0.f), a2 = fmaxf(s[2], 0.f), a3 = fmaxf(s[3], 0.f);
                    v2u w; w.x = pk2(a0 * a0, a1 * a1); w.y = pk2(a2 * a2, a3 * a3); *(v2u*)(ACTS + row * DFF + col) = w;
                    __syncthreads();
                }
            }
            unsigned char* ws = KWS();
            pg8::Gemm g{(const bf16*)(ws + ((l & 1) ? WS_HB1 : WS_HB0)), (const bf16*)(ws + WS_W + l * W_LAYER + W_UP), M, DFF, D}; pg8::StaticOrder S; S.init(M, DFF, G, bx);
            pg8::EpiUp E{l};
            pg8::gemm_phase<pg8::EpiUp, pg8::StaticOrder, true, true>(lds + RING_OFF, g, S, E, wave);
            SEAM(pb + 3);
        }
        if (IN(pb + 4)) {
            PH_TID();
            if (bx < D / 64) {
                unsigned char* ws = KWS();
                float* HS = (float*)(ws + WS_SMP + SMP_HS); bf16* hsbx = (bf16*)(ws + WS_SMP + ((l & 1) ? SMP_HSB1 : SMP_HSB0));
                for (int t = bx; t < D / 64; t += G) {
                    const f32x4 s = sg_tile<DFF>((const bf16*)(ws + WS_SMP + SMP_ACTS), (const bf16*)(ws + WS_W + l * W_LAYER + W_DN), t * 64, red0, wave, lane, tid);
                    const int row = tid >> 4, col = t * 64 + (tid & 15) * 4;
                    const f32x4 o = *(const f32x4*)(HS + row * D + col) + s;
                    *(f32x4*)(HS + row * D + col) = o; v2u w; w.x = pk2(o[0], o[1]); w.y = pk2(o[2], o[3]); *(v2u*)(hsbx + row * D + col) = w;
                    sss_put((float*)(ws + WS_SMP + SMP_SSS) + 1024, row, t, o, tid);
                    __syncthreads();
                }
            }
            unsigned char* ws = KWS();
            pg8::Gemm g{(const bf16*)(ws + WS_ACT), (const bf16*)(ws + WS_W + l * W_LAYER + W_DN), M, D, DFF}; pg8::StaticOrder S; S.init(M, D, G, bx);
            pg8::EpiRes E{l, 1};
            pg8::gemm_phase<pg8::EpiRes, pg8::StaticOrder, false, true>(lds + RING_OFF, g, S, E, wave);
            SEAM(pb + 4);
        }
        if (IN(pb + 5)) {
            PH_TID();
            if (bx < D / 64) {
                unsigned char* ws = KWS();
                float* HS = (float*)(ws + WS_SMP + SMP_HS); bf16* hsby = (bf16*)(ws + WS_SMP + ((l & 1) ? SMP_HSB0 : SMP_HSB1));
                for (int t = bx; t < D / 64; t += G) {
                    const f32x4 gt = sg_tile<D>((const bf16*)(ws + WS_SMP + ((l & 1) ? SMP_HSB1 : SMP_HSB0)), (const bf16*)(ws + WS_W + l * W_LAYER + W_GT), t * 64, red0, wave, lane, tid) * (srstd((const float*)(ws + WS_SMP + SMP_SSS) + 1024, tid >> 4) * -1.4426950408889634f);
                    const f32x4 pe = sg_tile<DPLE>((const bf16*)(ws + WS_SMP + SMP_PSB) + (size_t)l * SB * DPLE, (const bf16*)(ws + WS_W + l * W_LAYER + W_PL), t * 64, red1, wave, lane, tid);
                    const int row = tid >> 4, col = t * 64 + (tid & 15) * 4;
                    f32x4 o = *(const f32x4*)(HS + row * D + col);
#pragma unroll
                    for (int e = 0; e < 4; ++e) o[e] += pe[e] * __builtin_amdgcn_rcpf(1.0f + __builtin_amdgcn_exp2f(gt[e]));
                    *(f32x4*)(HS + row * D + col) = o; v2u w; w.x = pk2(o[0], o[1]); w.y = pk2(o[2], o[3]); *(v2u*)(hsby + row * D + col) = w;
                    sss_put((float*)(ws + WS_SMP + SMP_SSS), row, t, o, tid);
                    __syncthreads();
                }
            }
            { unsigned char* ws = KWS();
              pg8::Gemm g{(const bf16*)(ws + WS_PB) + (size_t)l * M * DPLE, (const bf16*)(ws + WS_W + l * W_LAYER + W_PL), M, D, DPLE}; pg8::StaticOrder S; S.init(M, D, G, bx);
              pg8::EpiPlain E{D};
              pg8::gemm_phase<pg8::EpiPlain, pg8::StaticOrder, false, true>(lds + RING_OFF, g, S, E, wave); }
            { unsigned char* ws = KWS();
              pg8::Gemm g{(const bf16*)(ws + ((l & 1) ? WS_HB1 : WS_HB0)), (const bf16*)(ws + WS_W + l * W_LAYER + W_GT), M, D, D}; pg8::StaticOrder S; S.init(M, D, G, bx);
              pg8::EpiGate E{l};
              pg8::gemm_phase<pg8::EpiGate, pg8::StaticOrder, false, true>(lds + RING_OFF, g, S, E, wave); }
            SEAM(pb + 5);
        }
}
__global__ void __launch_bounds__(NWAVES * 64, 2) fwd(Args args) {
    extern __shared__ __attribute__((aligned(16))) unsigned char lds_raw[];
    LAS unsigned char* lds = (LAS unsigned char*)lds_raw;
    volatile LAS unsigned* MISC = (volatile LAS unsigned*)(lds + MISC_OFF);
    const int tid0 = threadIdx.x, wave = __builtin_amdgcn_readfirstlane(tid0 >> 6);
    const int G = gridDim.x, bx = blockIdx.x;
    for (int u = tid0; u < (LDS_BYTES - LDSCTL_OFF) / 4; u += NWAVES * 64) ((LAS unsigned*)(lds + LDSCTL_OFF))[u] = 0u;
    __syncthreads();
    const int lo = args.ph_lo, hi = args.ph_hi;
    XcdBarrier bar; bar.bar = nullptr; bar.x = 0; bar.st = MISC + 8;
    if (hi - lo > 1) bar = xcd_barrier_post((unsigned*)(KWS() + WS_CTL) + CW_BAR, MISC + 8);
    LAS float* red0 = (LAS float*)(lds + RING_OFF); LAS float* red1 = (LAS float*)(lds + RING_OFF + 65536);

    if (IN(0)) {
            PH_TID();
        const int vcu = (G % 8 == 0) ? (bx % 8) * (G / 8) + bx / 8 : bx;
        const int gw = vcu * NWAVES + wave, NGW = G * NWAVES;
        unsigned char* ws = KWS();
        LAS float* scr = (LAS float*)(lds + RING_OFF + wave * 16384);
        constexpr int I_FOLD = 256, I_IN = 512, I_OUT = 128, I_UP = 1024, I_DN = 1024, I_GT = 256, I_PL = 64, I_REST = I_IN + I_OUT + I_UP + I_DN + I_GT + I_PL;
        { const float* pool_w = KIN(8); const float* pool_scale = KIN(9); const float* w_out = KIN(10);
          for (int it = gw; it < NL * I_FOLD; it += NGW) { const int l = it / I_FOLD, r = it % I_FOLD;
            fold_item(pool_w + (size_t)l * 4 * 128 * 128, pool_scale + l * 512, w_out + (size_t)l * 1024 * 1024, (bf16*)(ws + WS_W + l * W_LAYER + W_OUT), scr, r, lane); } }
        for (int it = gw; it < NL * I_REST; it += NGW) { const int l = it / I_REST; int r = it % I_REST;
            unsigned char* wl = ws + WS_W + l * W_LAYER;
            const float* W; int N; const float* g; bf16* WT; int ldk;
            if (r < I_IN) { W = KIN(7) + (size_t)l * 1024 * 2048; N = 2048; g = KIN(6) + l * 1024; WT = (bf16*)(wl + W_IN); ldk = 1024; }
            else if ((r -= I_IN) < I_OUT) { W = KIN(10) + (size_t)l * 1024 * 1024; N = 1024; g = nullptr; WT = (bf16*)(wl + W_OUT); ldk = 1024; }
            else if ((r -= I_OUT) < I_UP) { W = KIN(12) + (size_t)l * 1024 * 4096; N = 4096; g = KIN(11) + l * 1024; WT = (bf16*)(wl + W_UP); ldk = 1024; }
            else if ((r -= I_UP) < I_DN) { W = KIN(13) + (size_t)l * 4096 * 1024; N = 1024; g = nullptr; WT = (bf16*)(wl + W_DN); ldk = 4096; }
            else if ((r -= I_DN) < I_GT) { W = KIN(15) + (size_t)l * 1024 * 1024; N = 1024; g = KIN(14) + l * 1024; WT = (bf16*)(wl + W_GT); ldk = 1024; }
            else { r -= I_GT; W = KIN(16) + (size_t)l * 256 * 1024; N = 1024; g = nullptr; WT = (bf16*)(wl + W_PL); ldk = 256; }
            tr_item(W, N, g, WT, ldk, r, lane); }
        { const float* x_prompt = KIN(0); bf16* HB0 = (bf16*)(ws + WS_HB0); float* SS_A = (float*)(ws + WS_SS);
          for (int m = gw; m < M; m += NGW) xrow_item(x_prompt + (size_t)m * D, HB0 + (size_t)m * D, SS_A + (size_t)m * 4, 4, nullptr, lane); }
        { const float* p_prompt = KIN(4); bf16* PB = (bf16*)(ws + WS_PB);
          for (int it = gw; it < NL * M * DPLE / 512; it += NGW) cvt_item(p_prompt, PB, it, lane); }
        { const float* x_sample = KIN(1); unsigned char* smp = ws + WS_SMP;
          for (int m = gw; m < SB; m += NGW) xrow_item(x_sample + (size_t)m * D, (bf16*)(smp + SMP_HSB0) + (size_t)m * D, (float*)(smp + SMP_SSS) + m * 16, 16, (float*)(smp + SMP_HS) + (size_t)m * D, lane);
          const float* p_sample = KIN(5);
          for (int it = gw; it < NL * SB * DPLE / 512; it += NGW) cvt_item(p_sample, (bf16*)(smp + SMP_PSB), it, lane); }
        VM_WAIT(); __syncthreads();
        SEAM(0);
    }

    layer_phases<0>(lds, lo, hi, G, bx, wave, bar);
    layer_phases<1>(lds, lo, hi, G, bx, wave, bar);
    layer_phases<2>(lds, lo, hi, G, bx, wave, bar);
    layer_phases<3>(lds, lo, hi, G, bx, wave, bar);
    if (IN(N_PHASES - 1)) {
            PH_TID();
        const int gw = bx * NWAVES + wave, NGW = G * NWAVES;
        unsigned char* ws = KWS(); float* outp = KOUT(); const float* g_final = KIN(17);
        const float* H = (const float*)(ws + WS_H); const float* SS_A = (const float*)(ws + WS_SS);
        for (int m = gw; m < M; m += NGW) final_row(H + (size_t)m * D, pg8::row_rstd(SS_A, m), g_final, outp + O_YP + (size_t)m * D, lane);
        for (int m = gw; m < SB; m += NGW) final_row((const float*)(ws + WS_SMP + SMP_HS) + (size_t)m * D, srstd((const float*)(ws + WS_SMP + SMP_SSS), m), g_final, outp + O_YS + (size_t)m * D, lane);
    }
#undef IN
#undef SEAM
}

extern "C" void kernel_launch(void* const* d_in, const int* in_sizes, int n_in, void* d_out, int out_size, void* d_ws, size_t ws_size, hipStream_t stream) {
    static int grid = 0;
    if (grid == 0) {
        if (n_in != 18 || in_sizes[0] != M * D || (size_t)out_size != O_END || ws_size < WS_END) { fprintf(stderr, "kernel_launch: unexpected shapes (n_in %d, in0 %d, out %d, ws %zu); nothing launched\n", n_in, n_in > 0 ? in_sizes[0] : -1, out_size, ws_size); grid = -1; return; }
        int dev = 0, cus = 0, per_cu = 0;
        if (hipGetDevice(&dev) != hipSuccess || hipDeviceGetAttribute(&cus, hipDeviceAttributeMultiprocessorCount, dev) != hipSuccess) { fprintf(stderr, "kernel_launch: device query failed\n"); grid = -1; return; }
        if (hipFuncSetAttribute((const void*)fwd, hipFuncAttributeMaxDynamicSharedMemorySize, LDS_BYTES) != hipSuccess) { fprintf(stderr, "kernel_launch: hipFuncSetAttribute failed\n"); grid = -1; return; }
        if (hipOccupancyMaxActiveBlocksPerMultiprocessor(&per_cu, (const void*)fwd, NWAVES * 64, LDS_BYTES) != hipSuccess || per_cu < 1) fprintf(stderr, "kernel_launch: note: occupancy query reports %d workgroups per CU\n", per_cu);
        (void)hipGetLastError();
        grid = cus;
        if (grid != 256) fprintf(stderr, "kernel_launch: %d CUs: this kernel is built for a 256-CU device\n", grid);
    }
    if (grid < 0) return;
    if (hipMemsetAsync((char*)d_ws + WS_CTL, 0, CTL_ZERO_BYTES, stream) != hipSuccess) { fprintf(stderr, "kernel_launch: memset failed\n"); return; }
    Args a{};
    for (int i = 0; i < 18; ++i) a.in[i] = (const float*)d_in[i];
    a.out = (float*)d_out; a.ws = (unsigned char*)d_ws;
#if MK_SPLIT
    for (int p = 0; p < N_PHASES; ++p) { a.ph_lo = p; a.ph_hi = p + 1; hipLaunchKernelGGL(fwd, dim3(grid), dim3(NWAVES * 64), LDS_BYTES, stream, a); }
#else
    a.ph_lo = 0; a.ph_hi = N_PHASES;
    hipLaunchKernelGGL(fwd, dim3(grid), dim3(NWAVES * 64), LDS_BYTES, stream, a);
#endif
    const hipError_t le = hipPeekAtLastError();
    if (le != hipSuccess) fprintf(stderr, "kernel_launch: launch failed: %s\n", hipGetErrorName(le));
}
```

```cpp
#include <hip/hip_runtime.h>
#include <cstdio>
#include <cstdint>
#ifndef MK_SPLIT
#define MK_SPLIT 0
#endif
constexpr int NWAVES = 8;

constexpr int NL = 4, NB = 2, SEQ = 8192, M = NB * SEQ, D = 1024, DIN = 2048, DFF = 4096, DPLE = 256, SB = 32, WBUF = 2048, PBUF = 15, DP = 512;
constexpr float QSCALE = 0.125f * 1.4426950408889634f;
constexpr int N_PHASES = 2 + 6 * NL;
constexpr size_t O_YP = 0, O_YS = (size_t)M * D, O_KVP = O_YS + (size_t)SB * D, O_KVS = O_KVP + (size_t)NL * NB * WBUF * 1024, O_PP = O_KVS + (size_t)NL * SB * 1024,
                 O_PS = O_PP + (size_t)NL * NB * PBUF * DP, O_END = O_PS + (size_t)NL * SB * PBUF * DP;
static_assert(O_END == 34762752, "d_out size");

constexpr size_t MiB = 1u << 20, KiB = 1u << 10;
constexpr size_t WS_CTL = 0, CTL_ZERO_BYTES = 1 * MiB;
constexpr size_t WS_W = 2 * MiB, W_LAYER = 25 * MiB;
constexpr size_t W_IN = 0, W_OUT = 4 * MiB, W_UP = 6 * MiB, W_DN = 14 * MiB, W_GT = 22 * MiB, W_PL = 24 * MiB;
constexpr size_t WS_HB0 = 104 * MiB, WS_HB1 = 136 * MiB;
constexpr size_t WS_H = 168 * MiB;
constexpr size_t WS_QKVU = 232 * MiB;
constexpr size_t WS_AO = 296 * MiB;
constexpr size_t WS_ACT = 328 * MiB;
constexpr size_t WS_PE = 456 * MiB;
constexpr size_t WS_PB = 488 * MiB;
constexpr size_t WS_OPART = 520 * MiB;
constexpr size_t WS_LSE = 568 * MiB;
constexpr size_t WS_SS = 570 * MiB;
constexpr size_t WS_SMP = 572 * MiB;
constexpr size_t WS_END = 576 * MiB;
constexpr size_t SMP_HS = 0, SMP_HSB0 = 128 * KiB, SMP_HSB1 = 192 * KiB, SMP_QS = 256 * KiB, SMP_AOS = 320 * KiB, SMP_ACTS = 384 * KiB, SMP_PSB = 640 * KiB, SMP_SSS = 704 * KiB;
constexpr int CW_TMO = 0, CW_BAR = 4096;

constexpr int RING_OFF = 0, RING_BYTES = 131072;
constexpr int LDSCTL_OFF = RING_BYTES, MISC_OFF = LDSCTL_OFF + 320;
constexpr int LDS_BYTES = 147456;
static_assert(MISC_OFF + 128 <= LDS_BYTES, "LDS map");

#define GAS __attribute__((address_space(1)))
#define LAS __attribute__((address_space(3)))
typedef unsigned short bf16;
typedef unsigned v4u __attribute__((ext_vector_type(4)));
typedef unsigned v2u __attribute__((ext_vector_type(2)));
typedef float f32x4 __attribute__((ext_vector_type(4)));
typedef float f32x16 __attribute__((ext_vector_type(16)));
typedef short bf16x8 __attribute__((ext_vector_type(8)));
typedef short s16x4 __attribute__((ext_vector_type(4)));
typedef GAS unsigned gu32;
#define LDS_WAIT() asm volatile("s_waitcnt lgkmcnt(0)" ::: "memory")
#define VM_WAIT() asm volatile("s_waitcnt vmcnt(0)" ::: "memory")
__device__ __forceinline__ unsigned f2bf(float f) { unsigned u = __builtin_bit_cast(unsigned, f); return (u + 0x7fffu + ((u >> 16) & 1u)) >> 16; }
__device__ __forceinline__ unsigned pk2(float lo, float hi) { return f2bf(lo) | (f2bf(hi) << 16); }
__device__ __forceinline__ float bflo(unsigned w) { return __uint_as_float(w << 16); }
__device__ __forceinline__ float bfhi(unsigned w) { return __uint_as_float(w & 0xffff0000u); }
__device__ __forceinline__ float wave_sum(float v) {
#pragma unroll
    for (int o = 1; o < 64; o <<= 1) v += __shfl_xor(v, o);
    return v;
}

template <int OFF> __device__ __forceinline__ unsigned long long karg64() {
    unsigned long long v;
    asm volatile("s_load_dwordx2 %0, %1, %2\n\ts_waitcnt lgkmcnt(0)" : "=s"(v) : "s"(__builtin_amdgcn_kernarg_segment_ptr()), "i"(OFF));
    return v;
}
#define KIN(i) ((const float*)(const GAS float*)karg64<8 * (i)>())
#define KOUT() ((float*)(GAS float*)karg64<144>())
#define KWS() ((unsigned char*)(GAS unsigned char*)karg64<152>())

namespace pg8 {
#define PG8_LAS __attribute__((address_space(3)))
typedef unsigned short bf16_t;
typedef short bf16x8 __attribute__((ext_vector_type(8)));
typedef float f32x4 __attribute__((ext_vector_type(4)));
typedef unsigned u32x4 __attribute__((ext_vector_type(4)));
constexpr int BM = 256, BK = 64, HALF = 128, HTB = HALF * BK * 2  , STAGE_BYTES = 8 * HTB, NXCD = 8, WGM = 8;

__host__ __device__ __forceinline__ int lds_byte(int r, int c) { const int st = (r >> 4) * 2 + (c >> 5), rr = r & 15, cc = c & 31, ob = rr * 64 + cc * 2; return st * 1024 + (ob ^ (((ob >> 9) & 1) << 5)); }
__host__ __device__ __forceinline__ void stage_rc(int b, int& R, int& C) { const int st = b / 1024, sb = b % 1024, swz = sb ^ (((sb >> 9) & 1) << 5); R = (st >> 1) * 16 + swz / 64; C = (st & 1) * 32 + (swz % 64) / 2; }
__host__ __device__ __forceinline__ int perm32(int rho) { const int n = rho >> 4, i = rho & 15; return 8 * (i >> 2) + 4 * n + (i & 3); }

struct Unit { int pm, pn; };
struct Gemm { const bf16_t* A; const bf16_t* Bt; int M, N, K; };

struct StaticOrder {
    int nM, nN, nwg, G, c;
    __host__ __device__ void init(int M, int N, int G_, int c_) { nM = M / BM; nN = N / BM; nwg = nM * nN; G = G_; c = c_; }
    __host__ __device__ bool next(int i, Unit& u) const {
        const long L = (long)i * G + c; if (L >= nwg) return false;
        int wgid = (int)L; { const int q = nwg / NXCD, r = nwg % NXCD, xcd = wgid % NXCD, off = wgid / NXCD; wgid = (xcd < r ? xcd * (q + 1) : r * (q + 1) + (xcd - r) * q) + off; }
        const int nig = WGM * nN, gid = wgid / nig, fm = gid * WGM, gsz = (nM - fm) < WGM ? (nM - fm) : WGM;
        u.pm = fm + ((wgid % nig) % gsz); u.pn = (wgid % nig) / gsz; return true;
    }
    __device__ __forceinline__ void a_ready(const Unit&) const {}
    __device__ __forceinline__ void done(const Unit&) const {}
};

__device__ __forceinline__ unsigned cvt_pk_bf16(float lo, float hi) { unsigned r; asm volatile("v_cvt_pk_bf16_f32 %0, %1, %2" : "=v"(r) : "v"(lo), "v"(hi)); return r; }
typedef float f32x2 __attribute__((ext_vector_type(2)));
typedef unsigned u32x2 __attribute__((ext_vector_type(2)));
__device__ __forceinline__ u32x4 pack8(const f32x4 a, const f32x4 b) { u32x4 w; w.x = cvt_pk_bf16(a[0], a[1]); w.y = cvt_pk_bf16(a[2], a[3]); w.z = cvt_pk_bf16(b[0], b[1]); w.w = cvt_pk_bf16(b[2], b[3]); return w; }
__device__ __forceinline__ float dot4(const f32x4 a) { return (a[0] * a[0] + a[1] * a[1]) + (a[2] * a[2] + a[3] * a[3]); }
__device__ __forceinline__ float row_rstd(const float* ss, int row) { const f32x4 s = *(const f32x4*)(ss + (size_t)row * 4); return __builtin_amdgcn_rsqf(((s[0] + s[1]) + (s[2] + s[3])) * (1.0f / 1024.0f) + 1e-6f); }
__device__ __forceinline__ void unpack8(const u32x4 w, f32x4& a, f32x4& b) {
    a[0] = __uint_as_float(w.x << 16); a[1] = __uint_as_float(w.x & 0xffff0000u); a[2] = __uint_as_float(w.y << 16); a[3] = __uint_as_float(w.y & 0xffff0000u);
    b[0] = __uint_as_float(w.z << 16); b[1] = __uint_as_float(w.z & 0xffff0000u); b[2] = __uint_as_float(w.w << 16); b[3] = __uint_as_float(w.w & 0xffff0000u); }

struct EpiPlain {
    static constexpr bool PERM = true, AFTER_DRAIN = false;
    int ldc;
    __device__ __forceinline__ void operator()(const f32x4 (&acc)[2][2][4][2], const Unit& u, int wr, int wc, int fr, int fq) const {
        asm volatile("" : "+v"(fr), "+v"(fq));
        bf16_t* O = (bf16_t*)(KWS() + WS_PE);
        const int row0 = u.pm * BM + wr * 64 + fr, col0 = u.pn * BM + wc * 32 + 8 * fq;
#pragma unroll
        for (int ai = 0; ai < 2; ++ai)
#pragma unroll
            for (int m = 0; m < 4; ++m) { bf16_t* rowp = O + (size_t)(row0 + ai * HALF + m * 16) * ldc + col0;
#pragma unroll
                for (int bj = 0; bj < 2; ++bj) *(u32x4*)(rowp + bj * HALF) = pack8(acc[ai][bj][m][0], acc[ai][bj][m][1]); }
    }
};
struct EpiProj {
    static constexpr bool PERM = true, AFTER_DRAIN = false;
    int l;
    __device__ __forceinline__ void operator()(const f32x4 (&acc)[2][2][4][2], const Unit& u, int wr, int wc, int fr, int fq) const {
        asm volatile("" : "+v"(fr), "+v"(fq));
        unsigned char* ws = KWS(); float* outp = KOUT();
        bf16_t* O = (bf16_t*)(ws + WS_QKVU); const float* ss = (const float*)(ws + WS_SS);
        float* kv_out = outp + O_KVP + (size_t)l * NB * WBUF * 1024; float* pool_out = outp + O_PP + (size_t)l * NB * PBUF * DP;
        const int row0 = u.pm * BM + wr * 64 + fr, col0 = u.pn * BM + wc * 32 + 8 * fq;
        const float sc = (u.pn < 2) ? QSCALE : 1.0f;
        const int b = u.pm >> 5, t0 = (u.pm & 31) * BM + wr * 64 + fr;
        const bool kvt = (u.pn >= 2) && (u.pn < 6) && ((u.pm & 31) >= 24);
        const bool plt = (u.pn >= 6) && ((u.pm & 31) == 31);
#pragma unroll
        for (int ai = 0; ai < 2; ++ai)
#pragma unroll
            for (int m = 0; m < 4; ++m) { const int row = row0 + ai * HALF + m * 16, t = t0 + ai * HALF + m * 16;
                const float rs = row_rstd(ss, row);
#pragma unroll
                for (int bj = 0; bj < 2; ++bj) { const int col = col0 + bj * HALF;
                    const f32x4 v0 = acc[ai][bj][m][0] * rs, v1 = acc[ai][bj][m][1] * rs;
                    *(u32x4*)(O + (size_t)row * 2048 + col) = pack8(v0 * sc, v1 * sc);
                    if (kvt) { float* p = kv_out + ((size_t)(b * 2048 + (t - 6144)) * 1024 + (col - 512)); *(f32x4*)p = v0; *(f32x4*)(p + 4) = v1; }
                    if (plt && t >= 8177) { float* p = pool_out + ((size_t)(b * 15 + (t - 8177)) * 512 + (col - 1536)); *(f32x4*)p = v0; *(f32x4*)(p + 4) = v1; } } }
    }
};
struct EpiUp {
    static constexpr bool PERM = true, AFTER_DRAIN = false;
    int l;
    __device__ __forceinline__ void operator()(const f32x4 (&acc)[2][2][4][2], const Unit& u, int wr, int wc, int fr, int fq) const {
        asm volatile("" : "+v"(fr), "+v"(fq));
        unsigned char* ws = KWS();
        bf16_t* O = (bf16_t*)(ws + WS_ACT); const float* ss = (const float*)(ws + WS_SS) + (size_t)M * 4;
        const int row0 = u.pm * BM + wr * 64 + fr, col0 = u.pn * BM + wc * 32 + 8 * fq;
#pragma unroll
        for (int ai = 0; ai < 2; ++ai)
#pragma unroll
            for (int m = 0; m < 4; ++m) { const int row = row0 + ai * HALF + m * 16;
                const float rs = row_rstd(ss, row);
#pragma unroll
                for (int bj = 0; bj < 2; ++bj) {
                    f32x4 v0 = acc[ai][bj][m][0] * rs, v1 = acc[ai][bj][m][1] * rs;
#pragma unroll
                    for (int e = 0; e < 4; ++e) { const float a = fmaxf(v0[e], 0.f), c = fmaxf(v1[e], 0.f); v0[e] = a * a; v1[e] = c * c; }
                    const u32x4 pk = pack8(v0, v1);
#ifdef REP_EPI4
                    for (int rep = 0; rep < REP_EPI4; ++rep) { asm volatile("" ::: "memory"); *(u32x4*)(O + (size_t)row * 4096 + col0 + bj * HALF) = pk; }
#else
                    *(u32x4*)(O + (size_t)row * 4096 + col0 + bj * HALF) = pk;
#endif
                    } }
    }
};
__device__ __forceinline__ void ss_finish(PG8_LAS unsigned char* lds, float* ssout, const Unit& u) {
    asm volatile("s_waitcnt lgkmcnt(0)" ::: "memory"); __builtin_amdgcn_s_barrier(); asm volatile("" ::: "memory");
    if (threadIdx.x < 256) { const f32x4 p = *(const PG8_LAS f32x4*)(lds + threadIdx.x * 16); ssout[(size_t)(u.pm * BM + threadIdx.x) * 4 + u.pn] = (p[0] + p[1]) + (p[2] + p[3]); }
}
struct EpiRes {
    static constexpr bool PERM = true, AFTER_DRAIN = true;
    int l, which, dummy;
    __device__ __forceinline__ void fused(f32x4 (&acc)[2][2][4][2], const Unit& u, int wr, int wc, int fr, int fq, PG8_LAS unsigned char* lds, int wid, int lane) const {
        asm volatile("" : "+v"(fr), "+v"(fq));
        unsigned char* ws = KWS();
        const bf16_t* base = (const bf16_t*)(ws + ((l & 1) ? WS_HB1 : WS_HB0)); bf16_t* hb = dummy ? (bf16_t*)(ws + WS_H) : (bf16_t*)(ws + ((l & 1) ? WS_HB1 : WS_HB0));
        float* ssout = (float*)(ws + WS_SS) + (size_t)(1 + which) * M * 4;
        PG8_LAS float* P = (PG8_LAS float*)lds;
        const int row0 = u.pm * BM + wr * 64 + fr, col0 = u.pn * BM + wc * 32 + 8 * fq;
#pragma unroll
        for (int ai = 0; ai < 2; ++ai)
#pragma unroll
            for (int m = 0; m < 4; ++m) { const size_t off = (size_t)(row0 + ai * HALF + m * 16) * 1024 + col0; float q = 0.f;
#pragma unroll
                for (int bj = 0; bj < 2; ++bj) {
                    f32x4 b0, b1; unpack8(*(const u32x4*)(base + off + bj * HALF), b0, b1);
                    const f32x4 o0 = b0 + acc[ai][bj][m][0], o1 = b1 + acc[ai][bj][m][1];
                    *(u32x4*)(hb + off + bj * HALF) = pack8(o0, o1);
                    q += dot4(o0) + dot4(o1); }
                q += __shfl_xor(q, 16); q += __shfl_xor(q, 32);
                if (fq == 0) P[(ai * HALF + wr * 64 + m * 16 + fr) * 4 + wc] = q; }
        ss_finish(lds, ssout, u);
    }
};
struct EpiGate {
    static constexpr bool PERM = true, AFTER_DRAIN = true;
    int l, dummy;
    __device__ __forceinline__ void fused(f32x4 (&acc)[2][2][4][2], const Unit& u, int wr, int wc, int fr, int fq, PG8_LAS unsigned char* lds, int wid, int lane) const {
        asm volatile("" : "+v"(fr), "+v"(fq));
        unsigned char* ws = KWS();
        const bf16_t* base = (const bf16_t*)(ws + ((l & 1) ? WS_HB1 : WS_HB0)); bf16_t* hb = dummy ? (bf16_t*)(ws + WS_H) : (bf16_t*)(ws + ((l & 1) ? WS_HB0 : WS_HB1)); const bf16_t* pe = (const bf16_t*)(ws + WS_PE);
        const float* ssin = (const float*)(ws + WS_SS) + (size_t)2 * M * 4; float* ssout = (float*)(ws + WS_SS);
        PG8_LAS float* P = (PG8_LAS float*)lds;
        const int row0 = u.pm * BM + wr * 64 + fr, col0 = u.pn * BM + wc * 32 + 8 * fq;
#pragma unroll
        for (int ai = 0; ai < 2; ++ai)
#pragma unroll
            for (int m = 0; m < 4; ++m) { const int row = row0 + ai * HALF + m * 16; const size_t off = (size_t)row * 1024 + col0; float q = 0.f;
                const float rs = row_rstd(ssin, row);
#pragma unroll
                for (int bj = 0; bj < 2; ++bj) {
                    f32x4 p0, p1, b0, b1; unpack8(*(const u32x4*)(pe + off + bj * HALF), p0, p1); unpack8(*(const u32x4*)(base + off + bj * HALF), b0, b1);
                    f32x4 g0 = acc[ai][bj][m][0] * (rs * -1.4426950408889634f), g1 = acc[ai][bj][m][1] * (rs * -1.4426950408889634f);
#pragma unroll
                    for (int e = 0; e < 4; ++e) { g0[e] = __builtin_amdgcn_rcpf(1.0f + __builtin_amdgcn_exp2f(g0[e])); g1[e] = __builtin_amdgcn_rcpf(1.0f + __builtin_amdgcn_exp2f(g1[e])); }
                    const f32x4 o0 = b0 + p0 * g0, o1 = b1 + p1 * g1;
                    *(u32x4*)(hb + off + bj * HALF) = pack8(o0, o1);
                    q += dot4(o0) + dot4(o1); }
                q += __shfl_xor(q, 16); q += __shfl_xor(q, 32);
                if (fq == 0) P[(ai * HALF + wr * 64 + m * 16 + fr) * 4 + wc] = q; }
        ss_finish(lds, ssout, u);
    }
};

template <class Epi, class Sched, bool ALIGN_EPI = false, bool SP2 = false>
__device__ __forceinline__ void gemm_phase(PG8_LAS unsigned char* lds, const Gemm g, const Sched& S, const Epi& E, int wave_id) {
    int lane = (int)__builtin_amdgcn_mbcnt_hi(~0u, __builtin_amdgcn_mbcnt_lo(~0u, 0u)), widv = wave_id; asm volatile("" : "+v"(lane), "+v"(widv)); const int wid = __builtin_amdgcn_readfirstlane(widv);
    const int tid = wid * 64 + lane, wr = wid >> 2, wc = wid & 3, fr = lane & 15, fq = lane >> 4;
    const int K = g.K, nt = K / BK;
    unsigned voffA[2], voffB[2];
#pragma unroll
    for (int i = 0; i < 2; ++i) { int R, C; stage_rc(tid * 16 + i * 8192, R, C); const int Rb = Epi::PERM ? ((R & ~31) + perm32(R & 31)) : R;
        voffA[i] = (unsigned)(R * K + C) * 2u; voffB[i] = (unsigned)(Rb * K + C) * 2u; }
    const size_t kstep = (size_t)(BK * 2);
    const size_t hstep = (size_t)HALF * K * 2;
    const size_t tstep = 2 * hstep;
    const unsigned ldsw = (unsigned)wid * 1024u;
    const int aoff = lds_byte(wr * 64 + fr, fq * 8), boff = lds_byte(wc * 32 + fr, fq * 8);
#define PG8_SA(b, h) (((b) * 2 + (h)) * HTB)
#define PG8_SB(b, h) ((4 + (b) * 2 + (h)) * HTB)
#define PG8_STAGE(bufoff, gbase, voff) do { _Pragma("unroll") for (int _i = 0; _i < 2; ++_i) \
        __builtin_amdgcn_global_load_lds((const unsigned*)((const char*)(gbase) + (voff)[_i]), (PG8_LAS unsigned*)(lds + (bufoff) + ldsw + _i * 8192), 16, 0, 0); } while (0)
#define PG8_LDA(dst, b, h) do { _Pragma("unroll") for (int m = 0; m < 4; ++m) _Pragma("unroll") for (int k = 0; k < 2; ++k) dst[m][k] = *(const PG8_LAS bf16x8*)(lds + PG8_SA(b, h) + aoff + m * 2048 + k * 1024); } while (0)
#define PG8_LDB(dst, b, h) do { _Pragma("unroll") for (int n = 0; n < 2; ++n) _Pragma("unroll") for (int k = 0; k < 2; ++k) dst[n][k] = *(const PG8_LAS bf16x8*)(lds + PG8_SB(b, h) + boff + n * 2048 + k * 1024); } while (0)
#define PG8_MMA(ai, bj, At, Bt) do { __builtin_amdgcn_s_setprio(1); _Pragma("unroll") for (int m = 0; m < 4; ++m) _Pragma("unroll") for (int n = 0; n < 2; ++n) _Pragma("unroll") for (int k = 0; k < 2; ++k) \
        acc[ai][bj][m][n] = __builtin_amdgcn_mfma_f32_16x16x32_bf16(Bt[n][k], At[m][k], acc[ai][bj][m][n], 0, 0, 0); __builtin_amdgcn_s_setprio(0); } while (0)
#define PG8_WAIT_V(n) asm volatile("s_waitcnt vmcnt(" #n ")" ::: "memory")
#define PG8_WAIT_L(n) asm volatile("s_waitcnt lgkmcnt(" #n ")" ::: "memory")
#define PG8_BAR __builtin_amdgcn_s_barrier()
#define PG8_SCHED __builtin_amdgcn_sched_barrier(0)
    Unit cur, nxt; int ui = 0;
    if (!S.next(0, cur)) return;
    f32x4 acc[2][2][4][2];
#pragma unroll
    for (int a = 0; a < 2; ++a)
#pragma unroll
        for (int b = 0; b < 2; ++b)
#pragma unroll
            for (int m = 0; m < 4; ++m)
#pragma unroll
                for (int n = 0; n < 2; ++n) acc[a][b][m][n] = (f32x4){0.f, 0.f, 0.f, 0.f};
    bf16x8 At[4][2], B0[2][2], B1[2][2];
    const char* cA = (const char*)g.A + (size_t)cur.pm * tstep; const char* cB = (const char*)g.Bt + (size_t)cur.pn * tstep;
    S.a_ready(cur);
    if constexpr (SP2) {
        PG8_STAGE(PG8_SB(0, 0), cB, voffB); PG8_STAGE(PG8_SB(0, 1), cB + hstep, voffB); PG8_STAGE(PG8_SA(0, 0), cA, voffA); PG8_STAGE(PG8_SA(0, 1), cA + hstep, voffA);
        if (wr == 1) PG8_BAR;
        PG8_WAIT_V(2); PG8_BAR;
        PG8_STAGE(PG8_SB(1, 0), cB + kstep, voffB); PG8_STAGE(PG8_SA(1, 0), cA + kstep, voffA); PG8_STAGE(PG8_SB(1, 1), cB + hstep + kstep, voffB);
        PG8_WAIT_V(6); PG8_BAR;
    } else {
        PG8_STAGE(PG8_SB(0, 0), cB, voffB); PG8_STAGE(PG8_SA(0, 0), cA, voffA); PG8_STAGE(PG8_SB(0, 1), cB + hstep, voffB); PG8_STAGE(PG8_SA(0, 1), cA + hstep, voffA);
        if (wr == 1) PG8_BAR;
        PG8_WAIT_V(4); PG8_BAR;
        PG8_STAGE(PG8_SB(1, 0), cB + kstep, voffB); PG8_STAGE(PG8_SA(1, 0), cA + kstep, voffA); PG8_STAGE(PG8_SB(1, 1), cB + hstep + kstep, voffB);
        PG8_WAIT_V(6); PG8_BAR;
    }
    for (;;) {
        const bool has_next = S.next(ui + 1, nxt);
        const char* nA = has_next ? (const char*)g.A + (size_t)nxt.pm * tstep : cA; const char* nB = has_next ? (const char*)g.Bt + (size_t)nxt.pn * tstep : cB;
        for (int t = 0; t < nt; t += 2) {
            const bool last = (t == nt - 2);
            const char* a1 = cA + (size_t)(t + 1) * kstep;
            const char* a2 = last ? nA : cA + (size_t)(t + 2) * kstep; const char* b2 = last ? nB : cB + (size_t)(t + 2) * kstep;
            const char* a3 = a2 + kstep; const char* b3 = b2 + kstep;
            if (last && has_next) S.a_ready(nxt);
            if constexpr (SP2) {
            PG8_LDB(B0, 0, 0); PG8_LDB(B1, 0, 1); PG8_SCHED; PG8_LDA(At, 0, 0); PG8_STAGE(PG8_SA(1, 1), a1 + hstep, voffA);
            PG8_WAIT_V(8); PG8_WAIT_L(0); PG8_BAR; PG8_MMA(0, 0, At, B0); PG8_MMA(0, 1, At, B1); PG8_BAR; PG8_SCHED;
            PG8_LDA(At, 0, 1); PG8_STAGE(PG8_SB(0, 0), b2, voffB); PG8_STAGE(PG8_SB(0, 1), b2 + hstep, voffB); PG8_STAGE(PG8_SA(0, 0), a2, voffA);
            PG8_WAIT_V(8); PG8_WAIT_L(0); PG8_BAR; PG8_MMA(1, 0, At, B0); PG8_MMA(1, 1, At, B1); PG8_BAR; PG8_SCHED;
            PG8_LDB(B0, 1, 0); PG8_LDB(B1, 1, 1); PG8_SCHED; PG8_LDA(At, 1, 0); PG8_STAGE(PG8_SA(0, 1), a2 + hstep, voffA);
            PG8_WAIT_V(8); PG8_WAIT_L(0); PG8_BAR; PG8_MMA(0, 0, At, B0); PG8_MMA(0, 1, At, B1); PG8_BAR; PG8_SCHED;
            PG8_LDA(At, 1, 1); PG8_STAGE(PG8_SB(1, 0), b3, voffB); PG8_STAGE(PG8_SB(1, 1), b3 + hstep, voffB); PG8_STAGE(PG8_SA(1, 0), a3, voffA);
            PG8_WAIT_V(8); PG8_WAIT_L(0); PG8_BAR; PG8_MMA(1, 0, At, B0); PG8_MMA(1, 1, At, B1); PG8_BAR; PG8_SCHED;
            } else {
            PG8_LDB(B0, 0, 0); PG8_SCHED; PG8_LDA(At, 0, 0); PG8_STAGE(PG8_SA(1, 1), a1 + hstep, voffA);
            PG8_WAIT_L(8); PG8_BAR; PG8_WAIT_L(0); PG8_MMA(0, 0, At, B0); PG8_BAR; PG8_SCHED;
            PG8_LDB(B1, 0, 1); PG8_STAGE(PG8_SB(0, 0), b2, voffB);
            PG8_BAR; PG8_WAIT_L(0); PG8_MMA(0, 1, At, B1); PG8_BAR;
            PG8_LDA(At, 0, 1); PG8_STAGE(PG8_SA(0, 0), a2, voffA);
            PG8_BAR; PG8_WAIT_L(0); PG8_MMA(1, 0, At, B0); PG8_BAR; PG8_SCHED;
            PG8_STAGE(PG8_SB(0, 1), b2 + hstep, voffB);
            PG8_WAIT_V(6); PG8_BAR; PG8_MMA(1, 1, At, B1); PG8_BAR;
            PG8_LDB(B0, 1, 0); PG8_SCHED; PG8_LDA(At, 1, 0); PG8_STAGE(PG8_SA(0, 1), a2 + hstep, voffA);
            PG8_WAIT_L(8); PG8_BAR; PG8_WAIT_L(0); PG8_MMA(0, 0, At, B0); PG8_BAR; PG8_SCHED;
            PG8_LDB(B1, 1, 1); PG8_STAGE(PG8_SB(1, 0), b3, voffB);
            PG8_BAR; PG8_WAIT_L(0); PG8_MMA(0, 1, At, B1); PG8_BAR;
            PG8_LDA(At, 1, 1); PG8_STAGE(PG8_SA(1, 0), a3, voffA);
            PG8_BAR; PG8_WAIT_L(0); PG8_MMA(1, 0, At, B0); PG8_BAR; PG8_SCHED;
            PG8_STAGE(PG8_SB(1, 1), b3 + hstep, voffB);
            PG8_WAIT_V(6); PG8_BAR; PG8_MMA(1, 1, At, B1); PG8_BAR;
            }
        }
        if constexpr (ALIGN_EPI) { if (wr == 0) PG8_BAR; }
        if constexpr (!Epi::AFTER_DRAIN) { E(acc, cur, wr, wc, fr, fq); S.done(cur); }
        if (!has_next) break;
#pragma unroll
        for (int a = 0; a < 2; ++a)
#pragma unroll
            for (int b = 0; b < 2; ++b)
#pragma unroll
                for (int m = 0; m < 4; ++m)
#pragma unroll
                    for (int n = 0; n < 2; ++n) acc[a][b][m][n] = (f32x4){0.f, 0.f, 0.f, 0.f};
        cur = nxt; cA = nA; cB = nB; ++ui;
        if constexpr (ALIGN_EPI) { if (wr == 1) PG8_BAR; }
    }
    PG8_WAIT_V(0);
    if constexpr (!ALIGN_EPI) { if (wr == 0) PG8_BAR; }
    PG8_BAR;
    if constexpr (Epi::AFTER_DRAIN) { E.fused(acc, cur, wr, wc, fr, fq, lds, wid, lane); S.done(cur); }
#undef PG8_SA
#undef PG8_SB
#undef PG8_STAGE
#undef PG8_LDA
#undef PG8_LDB
#undef PG8_MMA
#undef PG8_WAIT_V
#undef PG8_WAIT_L
#undef PG8_BAR
#undef PG8_SCHED
}
}
#define XB_TMO      128
#define XB_XCNT(j)  (256  + 64 * (j))
#define XB_XSUB(j)  (1280 + 64 * (j))
#define XB_XGEN(j)  (2304 + 64 * (j))
#define XB_TOP      3328
#define XB_TOPGEN   3392
#define XCD_BAR_WORDS 3456
#define XB_SPIN_CAP (1u << 18)

__device__ __forceinline__ unsigned xb_ld(unsigned* p)              { return __hip_atomic_load(p, __ATOMIC_RELAXED, __HIP_MEMORY_SCOPE_AGENT); }
__device__ __forceinline__ unsigned xb_add(unsigned* p, unsigned v) { return __hip_atomic_fetch_add(p, v, __ATOMIC_RELAXED, __HIP_MEMORY_SCOPE_AGENT); }
__device__ __forceinline__ unsigned xb_xcc_id() { return (unsigned)__builtin_amdgcn_s_getreg((3 << 11) | 20) & 0xFu; }
#define XB_SPIN(cond, bar) do { unsigned _sp = 0; while (cond) { __builtin_amdgcn_s_sleep(1); \
    if ((++_sp & 255u) == 0u) { if (xb_ld(&(bar)[XB_TMO])) break; if (_sp > XB_SPIN_CAP) { atomicAdd(&(bar)[XB_TMO], 1u); break; } } } } while (0)

struct XcdBarrier {
    unsigned* bar; unsigned x;
    volatile LAS unsigned* st;
};

__device__ __forceinline__ XcdBarrier xcd_barrier_post(unsigned* bar, volatile LAS unsigned* st) {
    XcdBarrier b; b.bar = bar; b.x = xb_xcc_id(); b.st = st;
    if (threadIdx.x == 0) (void)xb_add(&bar[XB_XCNT(b.x)], 1u);
    return b;
}
__device__ __forceinline__ void xcd_barrier_complete(unsigned* bar, unsigned x, unsigned& nloc, unsigned& nx) {
    const unsigned G = gridDim.x * gridDim.y * gridDim.z;
    unsigned sum, cnt, mine, sp = 0u;
    for (;;) {
        sum = 0u; cnt = 0u; mine = 0u;
#pragma unroll
        for (unsigned j = 0; j < 16; ++j) { const unsigned c = xb_ld(&bar[XB_XCNT(j)]); sum += c; cnt += (c > 0u) ? 1u : 0u; mine = (j == x) ? c : mine; }
        if (sum == G) break;
        __builtin_amdgcn_s_sleep(1);
        if ((++sp & 255u) == 0u) { if (xb_ld(&bar[XB_TMO])) break; if (sp > XB_SPIN_CAP) { atomicAdd(&bar[XB_TMO], 1u); break; } }
    }
    nloc = mine > 0u ? mine : 1u; nx = cnt > 0u ? cnt : 1u;
}

__device__ __forceinline__ void xcd_barrier(const XcdBarrier& b) {
    asm volatile("s_waitcnt vmcnt(0)" ::: "memory");
    __syncthreads();
    if (threadIdx.x == 0) {
        unsigned* bar = b.bar;
        __builtin_amdgcn_s_waitcnt(0);
        unsigned nloc = b.st[0], nx = b.st[1];
        if (nloc == 0u) { xcd_barrier_complete(bar, b.x, nloc, nx); b.st[0] = nloc; b.st[1] = nx; }
        const unsigned old = xb_add(&bar[XB_XSUB(b.x)], 1u);
        const unsigned gen = old / nloc;
        if (old + 1u == (gen + 1u) * nloc) {
            __builtin_amdgcn_fence(__ATOMIC_RELEASE, "agent");
            asm volatile("s_waitcnt vmcnt(0)" ::: "memory");
            const unsigned og = xb_add(&bar[XB_TOP], 1u);
            const unsigned tg = og / nx;
            if (og + 1u == (tg + 1u) * nx) xb_add(&bar[XB_TOPGEN], 1u);
            else XB_SPIN(xb_ld(&bar[XB_TOPGEN]) == tg, bar);
            __builtin_amdgcn_fence(__ATOMIC_ACQUIRE, "agent");
            xb_add(&bar[XB_XGEN(b.x)], 1u);
            asm volatile("s_waitcnt vmcnt(0)" ::: "memory");
        } else {
            XB_SPIN(xb_ld(&bar[XB_XGEN(b.x)]) == gen, bar);
            __builtin_amdgcn_fence(__ATOMIC_ACQUIRE, "agent");
            asm volatile("s_waitcnt vmcnt(0)" ::: "memory");
        }
    }
    __syncthreads();
}

__device__ __forceinline__ void tr_item(const float* __restrict__ W, int N, const float* __restrict__ g, bf16* __restrict__ WT, int ldk, int item, int lane) {
    const int nblk = N >> 6, kb = item / nblk, nb = item - kb * nblk, k0 = kb << 6, n = (nb << 6) + lane;
    const float* src = W + (size_t)k0 * N + n;
    float v[64];
#pragma unroll
    for (int i = 0; i < 64; ++i) v[i] = src[(size_t)i * N];
    if (g) {
#pragma unroll
        for (int i = 0; i < 64; ++i) v[i] *= g[k0 + i];
    }
    v4u* dst = (v4u*)(WT + (size_t)n * ldk + k0);
#pragma unroll
    for (int j = 0; j < 8; ++j) { v4u o; o.x = pk2(v[8 * j], v[8 * j + 1]); o.y = pk2(v[8 * j + 2], v[8 * j + 3]); o.z = pk2(v[8 * j + 4], v[8 * j + 5]); o.w = pk2(v[8 * j + 6], v[8 * j + 7]); dst[j] = o; }
}
__device__ __forceinline__ void fold_item(const float* __restrict__ pw, const float* __restrict__ scale, const float* __restrict__ wout, bf16* __restrict__ WT, LAS float* scr, int item, int lane) {
    const int kb = item >> 4, nb = item & 15, kp0 = kb << 5, g = kp0 >> 7, c0 = kp0 & 127, n = (nb << 6) + lane;
    const f32x4* psrc = (const f32x4*)(pw + (size_t)(g * 128 + c0) * 128);
#pragma unroll
    for (int i = 0; i < 16; ++i) *(LAS f32x4*)(scr + (i * 64 + lane) * 4) = psrc[i * 64 + lane];
    LDS_WAIT(); asm volatile("" ::: "memory");
    const float* wsrc = wout + (size_t)(512 + g * 128) * 1024 + n;
    const float* ssrc = scale + g * 128;
    float acc[32];
#pragma unroll
    for (int i = 0; i < 32; ++i) acc[i] = 0.f;
    for (int d4 = 0; d4 < 32; ++d4) {
        const f32x4 s4 = *(const f32x4*)(ssrc + 4 * d4);
        const float v0 = wsrc[(size_t)(4 * d4 + 0) * 1024] * s4[0], v1 = wsrc[(size_t)(4 * d4 + 1) * 1024] * s4[1], v2 = wsrc[(size_t)(4 * d4 + 2) * 1024] * s4[2], v3 = wsrc[(size_t)(4 * d4 + 3) * 1024] * s4[3];
#pragma unroll
        for (int i = 0; i < 32; ++i) { const f32x4 p = *(const LAS f32x4*)(scr + i * 128 + 4 * d4); acc[i] += (p[0] * v0 + p[1] * v1) + (p[2] * v2 + p[3] * v3); }
    }
    v4u* dst = (v4u*)(WT + (size_t)n * 1024 + 512 + kp0);
#pragma unroll
    for (int j = 0; j < 4; ++j) { v4u o; o.x = pk2(acc[8 * j], acc[8 * j + 1]); o.y = pk2(acc[8 * j + 2], acc[8 * j + 3]); o.z = pk2(acc[8 * j + 4], acc[8 * j + 5]); o.w = pk2(acc[8 * j + 6], acc[8 * j + 7]); dst[j] = o; }
    LDS_WAIT(); asm volatile("" ::: "memory");
}
__device__ __forceinline__ void xrow_item(const float* __restrict__ xrow, bf16* __restrict__ orow, float* __restrict__ ssrow, int nss, float* __restrict__ copy, int lane) {
    const f32x4* xr = (const f32x4*)xrow + lane;
    f32x4 v[4]; float s = 0.f;
#pragma unroll
    for (int j = 0; j < 4; ++j) { v[j] = xr[64 * j]; s += (v[j][0] * v[j][0] + v[j][1] * v[j][1]) + (v[j][2] * v[j][2] + v[j][3] * v[j][3]); }
    s = wave_sum(s);
    v2u* o8 = (v2u*)orow + lane;
#pragma unroll
    for (int j = 0; j < 4; ++j) { v2u o; o.x = pk2(v[j][0], v[j][1]); o.y = pk2(v[j][2], v[j][3]); o8[64 * j] = o; }
    if (copy) {
#pragma unroll
        for (int j = 0; j < 4; ++j) ((f32x4*)copy + lane)[64 * j] = v[j];
    }
    if (lane < nss) ssrow[lane] = (lane == 0) ? s : 0.f;
}
__device__ __forceinline__ void cvt_item(const float* __restrict__ src, bf16* __restrict__ dst, int item, int lane) {
    const size_t idx = (size_t)item * 512 + lane * 8;
    const f32x4 a = *(const f32x4*)(src + idx), b = *(const f32x4*)(src + idx + 4);
    v4u o; o.x = pk2(a[0], a[1]); o.y = pk2(a[2], a[3]); o.z = pk2(b[0], b[1]); o.w = pk2(b[2], b[3]);
    *(v4u*)(dst + idx) = o;
}
__device__ __forceinline__ void final_row(const float* __restrict__ hrow, float rstd, const float* __restrict__ gf, float* __restrict__ yrow, int lane) {
#pragma unroll
    for (int j = 0; j < 4; ++j) { const f32x4 v = ((const f32x4*)hrow + lane)[64 * j], gg = ((const f32x4*)gf + lane)[64 * j]; ((f32x4*)yrow + lane)[64 * j] = v * rstd * gg; }
}

__device__ __forceinline__ void final_row_bf(const bf16* __restrict__ hrow, float rstd, const float* __restrict__ gf, float* __restrict__ yrow, int lane) {
#pragma unroll
    for (int j = 0; j < 2; ++j) { const v4u x = ((const v4u*)hrow + lane)[64 * j]; const f32x4 g0 = ((const f32x4*)gf)[(64 * j + lane) * 2], g1 = ((const f32x4*)gf)[(64 * j + lane) * 2 + 1];
        f32x4 a = {bflo(x.x), bfhi(x.x), bflo(x.y), bfhi(x.y)}, b = {bflo(x.z), bfhi(x.z), bflo(x.w), bfhi(x.w)};
        ((f32x4*)yrow)[(64 * j + lane) * 2] = a * rstd * g0; ((f32x4*)yrow)[(64 * j + lane) * 2 + 1] = b * rstd * g1; }
}

__device__ __forceinline__ int crow(int i, int hi) { return (i & 3) + 8 * (i >> 2) + 4 * hi; }
__device__ __forceinline__ s16x4 vtr(LAS unsigned char* p) { typedef short v4i16_t __attribute__((ext_vector_type(4))); return __builtin_bit_cast(s16x4, __builtin_amdgcn_ds_read_tr16_b64_v4i16((LAS v4i16_t*)p)); }
__device__ __forceinline__ unsigned cvtpk(float lo, float hi) { typedef float f2 __attribute__((ext_vector_type(2))); typedef __bf16 b2 __attribute__((ext_vector_type(2))); f2 v = {lo, hi}; b2 b = __builtin_convertvector(v, b2); return __builtin_bit_cast(unsigned, b); }
__device__ __forceinline__ void attn_tile(const bf16* __restrict__ X  , int h, int dsh, int r, int c0, LAS unsigned char* vst  ,
                                          bf16* __restrict__ OP  , float* __restrict__ LS  , int lane) {
    const int r32 = lane & 31, hi = lane >> 5;
    const int nskip = (c0 < 128) ? ((128 - c0) >> 5) : 0;
    const float NEG = -1e30f;
    bf16x8 qf[4];
    { const bf16* qp = X + (size_t)(((c0 + r32) << dsh) + r) * 2048 + h * 64 + 8 * hi;
#pragma unroll
      for (int ds = 0; ds < 4; ++ds) qf[ds] = *(const bf16x8*)(qp + 16 * ds); }
    f32x16 s[5];
#pragma unroll
    for (int blk = 0; blk < 5; ++blk) {
        if (blk >= nskip) {
            const int kc = c0 - 128 + 32 * blk + r32;
            const bf16* kp = X + (size_t)((kc << dsh) + r) * 2048 + 512 + h * 64 + 8 * hi;
            f32x16 a;
#pragma unroll
            for (int i = 0; i < 16; ++i) a[i] = 0.f;
#pragma unroll
            for (int ds = 0; ds < 4; ++ds) a = __builtin_amdgcn_mfma_f32_32x32x16_bf16(*(const bf16x8*)(kp + 16 * ds), qf[ds], a, 0, 0, 0);
            s[blk] = a;
        } else {
#pragma unroll
            for (int i = 0; i < 16; ++i) s[blk][i] = NEG;
        }
    }
#pragma unroll
    for (int i = 0; i < 16; ++i) { const int kr = crow(i, hi); if (kr < r32) s[0][i] = NEG; if (kr > r32) s[4][i] = NEG; }
    float m = s[4][0];
#pragma unroll
    for (int blk = 0; blk < 5; ++blk)
#pragma unroll
        for (int i = 0; i < 16; ++i) m = fmaxf(m, s[blk][i]);
    m = fmaxf(m, __shfl_xor(m, 32));
    float l = 0.f;
#pragma unroll
    for (int blk = 0; blk < 5; ++blk)
#pragma unroll
        for (int i = 0; i < 16; ++i) { const float p = __builtin_amdgcn_exp2f(s[blk][i] - m); s[blk][i] = p; l += p; }
    l += __shfl_xor(l, 32);
    f32x16 o[2];
#pragma unroll
    for (int i = 0; i < 16; ++i) { o[0][i] = 0.f; o[1][i] = 0.f; }
    const int vrow8 = (lane >> 2) & 7, vc = (lane & 3) + 4 * (lane >> 5);
    const int vb = (4 * hi + ((lane & 15) >> 2)) * 64 + ((lane >> 4) & 1) * 32 + (lane & 3) * 8;
#pragma unroll
    for (int blk = 0; blk < 5; ++blk) {
        if (blk >= nskip) {
            LAS unsigned char* buf = vst + (blk & 1) * 4096;
            const int kb = c0 - 128 + 32 * blk;
            v4u vv[4];
#pragma unroll
            for (int i = 0; i < 4; ++i) { const int kc = kb + 8 * i + vrow8; vv[i] = *(const v4u*)(X + (size_t)((kc << dsh) + r) * 2048 + 1024 + h * 64 + 8 * vc); }
#pragma unroll
            for (int i = 0; i < 4; ++i) *(LAS v4u*)(buf + i * 1024 + lane * 16) = vv[i];
            LDS_WAIT(); asm volatile("" ::: "memory");
#pragma unroll
            for (int s2 = 0; s2 < 2; ++s2) {
                v4u pw; pw.x = cvtpk(s[blk][8 * s2 + 0], s[blk][8 * s2 + 1]); pw.y = cvtpk(s[blk][8 * s2 + 2], s[blk][8 * s2 + 3]); pw.z = cvtpk(s[blk][8 * s2 + 4], s[blk][8 * s2 + 5]); pw.w = cvtpk(s[blk][8 * s2 + 6], s[blk][8 * s2 + 7]);
                const bf16x8 pf = __builtin_bit_cast(bf16x8, pw);
#pragma unroll
                for (int d0 = 0; d0 < 2; ++d0) {
                    const s16x4 a = vtr(buf + vb + (2 * s2) * 1024 + d0 * 512), b = vtr(buf + vb + (2 * s2 + 1) * 1024 + d0 * 512);
                    const bf16x8 vf = (bf16x8){a[0], a[1], a[2], a[3], b[0], b[1], b[2], b[3]};
                    o[d0] = __builtin_amdgcn_mfma_f32_32x32x16_bf16(vf, pf, o[d0], 0, 0, 0);
                }
            }
            LDS_WAIT(); asm volatile("" ::: "memory");
        }
    }
    const float inv = 1.0f / l;
    const int tq = ((c0 + r32) << dsh) + r;
    bf16* op = OP + (size_t)tq * 512 + h * 64 + 4 * hi;
#pragma unroll
    for (int d0 = 0; d0 < 2; ++d0)
#pragma unroll
        for (int gq = 0; gq < 4; ++gq) { v2u w; w.x = cvtpk(o[d0][4 * gq] * inv, o[d0][4 * gq + 1] * inv); w.y = cvtpk(o[d0][4 * gq + 2] * inv, o[d0][4 * gq + 3] * inv); *(v2u*)(op + 32 * d0 + 8 * gq) = w; }
    if (hi == 0) LS[(size_t)tq * 8 + h] = m + __builtin_amdgcn_logf(l);
}
__device__ __forceinline__ void merge_z_unit(const bf16* __restrict__ QKVU, const bf16* __restrict__ OPART, const float* __restrict__ LSE, bf16* __restrict__ AO, int b, int h, int T0, int tid) {
    const int ch = tid & 7, tg = tid >> 3;
    const int w = 2 << (h >> 1);
    const size_t rowb = (size_t)b * SEQ;
    const bf16* ub = QKVU + rowb * 2048 + 1536 + h * 64 + 8 * ch;
    float sacc[8];
#pragma unroll
    for (int e = 0; e < 8; ++e) sacc[e] = 0.f;
    const int tfirst = T0 + 8 * tg;
    for (int j = 1; j < w; ++j) { const int tt = tfirst - j; if (tt >= 0) { const v4u x = *(const v4u*)(ub + (size_t)tt * 2048);
        sacc[0] += bflo(x.x); sacc[1] += bfhi(x.x); sacc[2] += bflo(x.y); sacc[3] += bfhi(x.y); sacc[4] += bflo(x.z); sacc[5] += bfhi(x.z); sacc[6] += bflo(x.w); sacc[7] += bfhi(x.w); } }
#pragma unroll 1
    for (int i = 0; i < 8; ++i) {
        const int t = tfirst + i; const size_t row = rowb + t;
        const float l0 = LSE[((size_t)0 * M + row) * 8 + h], l1 = LSE[((size_t)1 * M + row) * 8 + h], l2 = LSE[((size_t)2 * M + row) * 8 + h];
        const float mx = fmaxf(l0, fmaxf(l1, l2));
        float w0 = __builtin_amdgcn_exp2f(l0 - mx), w1 = __builtin_amdgcn_exp2f(l1 - mx), w2 = __builtin_amdgcn_exp2f(l2 - mx);
        const float inv = 1.0f / (w0 + w1 + w2); w0 *= inv; w1 *= inv; w2 *= inv;
        const v4u a0 = *(const v4u*)(OPART + ((size_t)0 * M + row) * 512 + h * 64 + 8 * ch), a1 = *(const v4u*)(OPART + ((size_t)1 * M + row) * 512 + h * 64 + 8 * ch), a2 = *(const v4u*)(OPART + ((size_t)2 * M + row) * 512 + h * 64 + 8 * ch);
        v4u oa;
        oa.x = pk2(w0 * bflo(a0.x) + w1 * bflo(a1.x) + w2 * bflo(a2.x), w0 * bfhi(a0.x) + w1 * bfhi(a1.x) + w2 * bfhi(a2.x));
        oa.y = pk2(w0 * bflo(a0.y) + w1 * bflo(a1.y) + w2 * bflo(a2.y), w0 * bfhi(a0.y) + w1 * bfhi(a1.y) + w2 * bfhi(a2.y));
        oa.z = pk2(w0 * bflo(a0.z) + w1 * bflo(a1.z) + w2 * bflo(a2.z), w0 * bfhi(a0.z) + w1 * bfhi(a1.z) + w2 * bfhi(a2.z));
        oa.w = pk2(w0 * bflo(a0.w) + w1 * bflo(a1.w) + w2 * bflo(a2.w), w0 * bfhi(a0.w) + w1 * bfhi(a1.w) + w2 * bfhi(a2.w));
        *(v4u*)(AO + row * 1024 + h * 64 + 8 * ch) = oa;
        const v4u x = *(const v4u*)(ub + (size_t)t * 2048);
        float u8[8] = {bflo(x.x), bfhi(x.x), bflo(x.y), bfhi(x.y), bflo(x.z), bfhi(x.z), bflo(x.w), bfhi(x.w)};
#pragma unroll
        for (int e = 0; e < 8; ++e) sacc[e] += u8[e];
        const float rc = 1.0f / (float)((t + 1 < w) ? (t + 1) : w);
        v4u oz; oz.x = pk2(sacc[0] * rc - u8[0], sacc[1] * rc - u8[1]); oz.y = pk2(sacc[2] * rc - u8[2], sacc[3] * rc - u8[3]); oz.z = pk2(sacc[4] * rc - u8[4], sacc[5] * rc - u8[5]); oz.w = pk2(sacc[6] * rc - u8[6], sacc[7] * rc - u8[7]);
        *(v4u*)(AO + row * 1024 + 512 + h * 64 + 8 * ch) = oz;
        const int td = t + 1 - w;
        if (td >= 0) { const v4u y = *(const v4u*)(ub + (size_t)td * 2048);
            sacc[0] -= bflo(y.x); sacc[1] -= bfhi(y.x); sacc[2] -= bflo(y.y); sacc[3] -= bfhi(y.y); sacc[4] -= bflo(y.z); sacc[5] -= bfhi(y.z); sacc[6] -= bflo(y.w); sacc[7] -= bfhi(y.w); }
    }
}

__device__ __forceinline__ void sample_attn_unit(const float* __restrict__ ckv  , const float* __restrict__ spool  ,
                                                 const float* __restrict__ QS, const float* __restrict__ kvnew  , float* __restrict__ psout  ,
                                                 bf16* __restrict__ AOS, int bs, int h, LAS float* red, int wave, int lane, int tid) {
    const int ks = lane >> 4, d4 = lane & 15;
    const f32x4 q4 = *(const f32x4*)(QS + bs * 512 + h * 64 + 4 * d4);
    const float* cb = ckv + (size_t)bs * 2048 * 1024 + h * 64 + 4 * d4;
    const float* nk = kvnew + bs * 1024 + h * 64 + 4 * d4;
    float sc[13]; f32x4 vv[13];
#pragma unroll
    for (int i = 0; i < 13; ++i) {
        const int idx = wave * 52 + i * 4 + ks; const bool valid = idx < 387;
        const int g = (idx >= 258) ? 2 : ((idx >= 129) ? 1 : 0), j = idx - g * 129;
        const float* kp = (valid && j > 0) ? (cb + (size_t)(2048 - (j << (2 * g))) * 1024) : nk;
        const f32x4 k4 = *(const f32x4*)kp; vv[i] = *(const f32x4*)(kp + 512);
        float d = (q4[0] * k4[0] + q4[1] * k4[1]) + (q4[2] * k4[2] + q4[3] * k4[3]);
        d += __shfl_xor(d, 1); d += __shfl_xor(d, 2); d += __shfl_xor(d, 4); d += __shfl_xor(d, 8);
        sc[i] = valid ? d : -1e30f;
    }
    float m = sc[0];
#pragma unroll
    for (int i = 1; i < 13; ++i) m = fmaxf(m, sc[i]);
    m = fmaxf(m, __shfl_xor(m, 16)); m = fmaxf(m, __shfl_xor(m, 32));
    float l = 0.f; f32x4 o = {0.f, 0.f, 0.f, 0.f};
#pragma unroll
    for (int i = 0; i < 13; ++i) { const float p = __builtin_amdgcn_exp2f(sc[i] - m); l += p; o += vv[i] * p; }
    l += __shfl_xor(l, 16); l += __shfl_xor(l, 32);
#pragma unroll
    for (int e = 0; e < 4; ++e) { o[e] += __shfl_xor(o[e], 16); o[e] += __shfl_xor(o[e], 32); }
    if (ks == 0) *(LAS f32x4*)(red + wave * 68 + 4 * d4) = o;
    if (lane == 0) { red[wave * 68 + 64] = m; red[wave * 68 + 65] = l; }
    __syncthreads();
    if (tid < 64) {
        float mm = red[64];
#pragma unroll
        for (int w = 1; w < 8; ++w) mm = fmaxf(mm, red[w * 68 + 64]);
        float L = 0.f, O = 0.f;
#pragma unroll
        for (int w = 0; w < 8; ++w) { const float f = __builtin_amdgcn_exp2f(red[w * 68 + 64] - mm); L += red[w * 68 + 65] * f; O += red[w * 68 + tid] * f; }
        AOS[bs * 1024 + h * 64 + tid] = (bf16)f2bf(O / L);
    } else if (tid < 128) {
        const int col = h * 64 + (tid - 64); const int w = 2 << (h >> 1);
        const float un = psout[(size_t)(bs * 15 + 14) * 512 + col];
        float s = un;
        for (int j = 1; j < w; ++j) s += spool[(size_t)(bs * 15 + (15 - j)) * 512 + col];
        AOS[bs * 1024 + 512 + col] = (bf16)f2bf(s / (float)w - un);
    } else if (tid < 192) {
        const int col = h * 64 + (tid - 128);
#pragma unroll
        for (int i = 0; i < 14; ++i) psout[(size_t)(bs * 15 + i) * 512 + col] = spool[(size_t)(bs * 15 + i + 1) * 512 + col];
    }
    __syncthreads();
}
template <int K> __device__ __forceinline__ f32x4 sg_tile(const bf16* __restrict__ A, const bf16* __restrict__ Bt, int n0, LAS float* red, int wave, int lane, int tid) {
    constexpr int KW = K / 8;
    f32x4 acc[2][4];
#pragma unroll
    for (int a = 0; a < 2; ++a)
#pragma unroll
        for (int c = 0; c < 4; ++c) acc[a][c] = (f32x4){0.f, 0.f, 0.f, 0.f};
    const int r16 = lane & 15, kq = lane >> 4;
    const bf16* ap = A + (size_t)r16 * K + wave * KW + 8 * kq;
    const bf16* bp = Bt + (size_t)(n0 + r16) * K + wave * KW + 8 * kq;
#pragma unroll 2
    for (int k = 0; k < KW; k += 32) {
        const bf16x8 a0 = *(const bf16x8*)(ap + k), a1 = *(const bf16x8*)(ap + (size_t)16 * K + k);
#pragma unroll
        for (int c = 0; c < 4; ++c) { const bf16x8 bb = *(const bf16x8*)(bp + (size_t)c * 16 * K + k);
            acc[0][c] = __builtin_amdgcn_mfma_f32_16x16x32_bf16(a0, bb, acc[0][c], 0, 0, 0); acc[1][c] = __builtin_amdgcn_mfma_f32_16x16x32_bf16(a1, bb, acc[1][c], 0, 0, 0); }
    }
#pragma unroll
    for (int a = 0; a < 2; ++a)
#pragma unroll
        for (int c = 0; c < 4; ++c)
#pragma unroll
            for (int i = 0; i < 4; ++i) red[(wave * 32 + 16 * a + 4 * kq + i) * 64 + 16 * c + r16] = acc[a][c][i];
    __syncthreads();
    const int row = tid >> 4, c4 = (tid & 15) * 4;
    f32x4 sum = (f32x4){0.f, 0.f, 0.f, 0.f};
#pragma unroll
    for (int w = 0; w < 8; ++w) sum += *(const LAS f32x4*)(red + (w * 32 + row) * 64 + c4);
    return sum;
}
__device__ __forceinline__ float srstd(const float* __restrict__ sss, int row) {
    const f32x4* p = (const f32x4*)(sss + row * 16); const f32x4 a = p[0] + p[1] + p[2] + p[3];
    return __builtin_amdgcn_rsqf(((a[0] + a[1]) + (a[2] + a[3])) * (1.0f / 1024.0f) + 1e-6f);
}
__device__ __forceinline__ void sss_put(float* __restrict__ sss, int row, int task, const f32x4 o, int tid) {
    float q = (o[0] * o[0] + o[1] * o[1]) + (o[2] * o[2] + o[3] * o[3]);
    q += __shfl_xor(q, 1); q += __shfl_xor(q, 2); q += __shfl_xor(q, 4); q += __shfl_xor(q, 8);
    if ((tid & 15) == 0) sss[row * 16 + task] = q;
}

struct Args { const float* in[18]; float* out; unsigned char* ws; int ph_lo, ph_hi; };
#define IN(k) (lo <= (k) && (k) < hi)
#ifndef REP_P0
#define REP_P0 1
#endif
#ifndef REP_P1
#define REP_P1 1
#endif
#ifndef REP_P2
#define REP_P2 1
#endif
#ifndef REP_P2S
#define REP_P2S 1
#endif
#ifndef REP_P4
#define REP_P4 1
#endif
#ifndef REP_P3
#define REP_P3 1
#endif
#ifndef REP_P5
#define REP_P5 1
#endif
#ifndef REP_P6
#define REP_P6 1
#endif
#ifndef REP_PE
#define REP_PE 1
#endif
#ifndef REP_S1
#define REP_S1 1
#endif
#ifndef REP_S4
#define REP_S4 1
#endif
#define SEAM(k) do { if (IN((k) + 1)) { bar.bar = (unsigned*)(KWS() + WS_CTL) + CW_BAR; xcd_barrier(bar); } } while (0)
#define PH_TID() int lane = (int)__builtin_amdgcn_mbcnt_hi(~0u, __builtin_amdgcn_mbcnt_lo(~0u, 0u)); asm volatile("" : "+v"(lane)); const int tid = wave * 64 + lane;
template <int L> __device__ __forceinline__ void layer_phases(LAS unsigned char* lds, const int lo, const int hi, const int G, const int bx, const int wave, XcdBarrier& bar) {
    constexpr int l = L;
    LAS float* red0 = (LAS float*)(lds + RING_OFF); LAS float* red1 = (LAS float*)(lds + RING_OFF + 65536);
        const int pb = 1 + 6 * l;
        if (IN(pb + 0)) {
            PH_TID();
            for (int rep = 0; rep < REP_S1; ++rep)
            if (bx < DIN / 64) {
                unsigned char* ws = KWS(); float* outp = KOUT();
                const bf16* hsbx = (const bf16*)(ws + WS_SMP + ((l & 1) ? SMP_HSB1 : SMP_HSB0));
                for (int t = bx; t < DIN / 64; t += G) {
                    const f32x4 v = sg_tile<D>(hsbx, (const bf16*)(ws + WS_W + l * W_LAYER + W_IN), t * 64, red0, wave, lane, tid) * srstd((const float*)(ws + WS_SMP + SMP_SSS), tid >> 4);
                    const int row = tid >> 4, col = t * 64 + (tid & 15) * 4;
                    if (col < 512) *(f32x4*)((float*)(ws + WS_SMP + SMP_QS) + row * 512 + col) = v * QSCALE;
                    else if (col < 1536) *(f32x4*)(outp + O_KVS + (size_t)l * SB * 1024 + row * 1024 + (col - 512)) = v;
                    else *(f32x4*)(outp + O_PS + (size_t)l * SB * PBUF * DP + (size_t)(row * 15 + 14) * 512 + (col - 1536)) = v;
                    __syncthreads();
                }
            }
            unsigned char* ws = KWS();
            pg8::Gemm g{(const bf16*)(ws + ((l & 1) ? WS_HB1 : WS_HB0)), (const bf16*)(ws + WS_W + l * W_LAYER + W_IN), M, DIN, D}; pg8::StaticOrder S; S.init(M, DIN, G, bx);
            pg8::EpiProj E{l};
            for (int rep = 0; rep < REP_P1; ++rep)
            pg8::gemm_phase<pg8::EpiProj, pg8::StaticOrder, true, true>(lds + RING_OFF, g, S, E, wave);
            SEAM(pb + 0);
        }
        if (IN(pb + 1)) {
            PH_TID();
            { unsigned char* ws = KWS(); float* outp = KOUT();
              const float* cache_kv = KIN(2) + (size_t)l * SB * 2048 * 1024; const float* state_pool = KIN(3) + (size_t)l * SB * PBUF * DP;
              for (int rep = 0; rep < REP_P2S; ++rep)
              for (int su = bx; su < SB * 8; su += G)
                sample_attn_unit(cache_kv, state_pool, (const float*)(ws + WS_SMP + SMP_QS), outp + O_KVS + (size_t)l * SB * 1024, outp + O_PS + (size_t)l * SB * PBUF * DP, (bf16*)(ws + WS_SMP + SMP_AOS), su >> 3, su & 7, red0, wave, lane, tid); }
            { unsigned char* ws = KWS();
              const bf16* QKVU = (const bf16*)(ws + WS_QKVU); bf16* OPART = (bf16*)(ws + WS_OPART); float* LSE = (float*)(ws + WS_LSE);
              for (int rep = 0; rep < REP_P2; ++rep)
              for (int uid = bx; uid < 256; uid += G) {
                const int h = uid & 7, bc = uid >> 3, b = bc >> 4, T0 = (bc & 15) * 512;
                const bf16* X = QKVU + (size_t)b * SEQ * 2048;
                LAS unsigned char* vst = lds + RING_OFF + 8192 + wave * 8192;
                for (int tile = wave; tile < 48; tile += 8) {
                    const int gp = tile >> 4, idx = tile & 15;
                    int dsh, r, c0;
                    if (gp == 0) { dsh = 0; r = 0; c0 = T0 + 32 * idx; }
                    else if (gp == 1) { dsh = 2; r = idx & 3; c0 = (T0 >> 2) + 32 * (idx >> 2); }
                    else { dsh = 4; r = idx; c0 = T0 >> 4; }
                    attn_tile(X, h, dsh, r, c0, vst, OPART + ((size_t)gp * M + (size_t)b * SEQ) * 512, LSE + ((size_t)gp * M + (size_t)b * SEQ) * 8, lane);
                }
                VM_WAIT(); __syncthreads();
                merge_z_unit(QKVU, OPART, LSE, (bf16*)(ws + WS_AO), b, h, T0, tid);
              } }
            SEAM(pb + 1);
        }
        if (IN(pb + 2)) {
            PH_TID();
            if (bx < D / 64) {
                unsigned char* ws = KWS();
                float* HS = (float*)(ws + WS_SMP + SMP_HS); bf16* hsbx = (bf16*)(ws + WS_SMP + ((l & 1) ? SMP_HSB1 : SMP_HSB0));
                for (int t = bx; t < D / 64; t += G) {
                    const f32x4 s = sg_tile<D>((const bf16*)(ws + WS_SMP + SMP_AOS), (const bf16*)(ws + WS_W + l * W_LAYER + W_OUT), t * 64, red0, wave, lane, tid);
                    const int row = tid >> 4, col = t * 64 + (tid & 15) * 4;
                    const f32x4 o = *(const f32x4*)(HS + row * D + col) + s;
                    *(f32x4*)(HS + row * D + col) = o; v2u w; w.x = pk2(o[0], o[1]); w.y = pk2(o[2], o[3]); *(v2u*)(hsbx + row * D + col) = w;
                    sss_put((float*)(ws + WS_SMP + SMP_SSS) + 512, row, t, o, tid);
                    __syncthreads();
                }
            }
            unsigned char* ws = KWS();
            pg8::Gemm g{(const bf16*)(ws + WS_AO), (const bf16*)(ws + WS_W + l * W_LAYER + W_OUT), M, D, D}; pg8::StaticOrder S; S.init(M, D, G, bx);
            for (int rep = 0; rep < REP_P3; ++rep) {
            pg8::EpiRes E{l, 0, rep < REP_P3 - 1};
            pg8::gemm_phase<pg8::EpiRes, pg8::StaticOrder, false, true>(lds + RING_OFF, g, S, E, wave); }
            SEAM(pb + 2);
        }
        if (IN(pb + 3)) {
            PH_TID();
            for (int rep = 0; rep < REP_S4; ++rep)
            if (bx < DFF / 64) {
                unsigned char* ws = KWS();
                bf16* ACTS = (bf16*)(ws + WS_SMP + SMP_ACTS);
                for (int t = bx; t < DFF / 64; t += G) {
                    const f32x4 s = sg_tile<D>((const bf16*)(ws + WS_SMP + ((l & 1) ? SMP_HSB1 : SMP_HSB0)), (const bf16*)(ws + WS_W + l * W_LAYER + W_UP), t * 64, red0, wave, lane, tid) * srstd((const float*)(ws + WS_SMP + SMP_SSS) + 512, tid >> 4);
                    const int row = tid >> 4, col = t * 64 + (tid & 15) * 4;
                    const float a0 = fmaxf(s[0], 0.f), a1 = fmaxf(s[1], 0.f), a2 = fmaxf(s[2], 0.f), a3 = fmaxf(s[3], 0.f);
                    v2u w; w.x = pk2(a0 * a0, a1 * a1); w.y = pk2(a2 * a2, a3 * a3); *(v2u*)(ACTS + row * DFF + col) = w;
                    __syncthreads();
                }
            }
            unsigned char* ws = KWS();
            pg8::Gemm g{(const bf16*)(ws + ((l & 1) ? WS_HB1 : WS_HB0)), (const bf16*)(ws + WS_W + l * W_LAYER + W_UP), M, DFF, D}; pg8::StaticOrder S; S.init(M, DFF, G, bx);
            pg8::EpiUp E{l};
            for (int rep = 0; rep < REP_P4; ++rep)
            pg8::gemm_phase<pg8::EpiUp, pg8::StaticOrder, true, true>(lds + RING_OFF, g, S, E, wave);
            SEAM(pb + 3);
        }
        if (IN(pb + 4)) {
            PH_TID();
            if (bx < D / 64) {
                unsigned char* ws = KWS();
                float* HS = (float*)(ws + WS_SMP + SMP_HS); bf16* hsbx = (bf16*)(ws + WS_SMP + ((l & 1) ? SMP_HSB1 : SMP_HSB0));
                for (int t = bx; t < D / 64; t += G) {
                    const f32x4 s = sg_tile<DFF>((const bf16*)(ws + WS_SMP + SMP_ACTS), (const bf16*)(ws + WS_W + l * W_LAYER + W_DN), t * 64, red0, wave, lane, tid);
                    const int row = tid >> 4, col = t * 64 + (tid & 15) * 4;
                    const f32x4 o = *(const f32x4*)(HS + row * D + col) + s;
                    *(f32x4*)(HS + row * D + col) = o; v2u w; w.x = pk2(o[0], o[1]); w.y = pk2(o[2], o[3]); *(v2u*)(hsbx + row * D + col) = w;
                    sss_put((float*)(ws + WS_SMP + SMP_SSS) + 1024, row, t, o, tid);
                    __syncthreads();
                }
            }
            unsigned char* ws = KWS();
            pg8::Gemm g{(const bf16*)(ws + WS_ACT), (const bf16*)(ws + WS_W + l * W_LAYER + W_DN), M, D, DFF}; pg8::StaticOrder S; S.init(M, D, G, bx);
            for (int rep = 0; rep < REP_P5; ++rep) {
            pg8::EpiRes E{l, 1, rep < REP_P5 - 1};
            pg8::gemm_phase<pg8::EpiRes, pg8::StaticOrder, false, true>(lds + RING_OFF, g, S, E, wave); }
            SEAM(pb + 4);
        }
        if (IN(pb + 5)) {
            PH_TID();
            if (bx < D / 64) {
                unsigned char* ws = KWS();
                float* HS = (float*)(ws + WS_SMP + SMP_HS); bf16* hsby = (bf16*)(ws + WS_SMP + ((l & 1) ? SMP_HSB0 : SMP_HSB1));
                for (int t = bx; t < D / 64; t += G) {
                    const f32x4 gt = sg_tile<D>((const bf16*)(ws + WS_SMP + ((l & 1) ? SMP_HSB1 : SMP_HSB0)), (const bf16*)(ws + WS_W + l * W_LAYER + W_GT), t * 64, red0, wave, lane, tid) * (srstd((const float*)(ws + WS_SMP + SMP_SSS) + 1024, tid >> 4) * -1.4426950408889634f);
                    const f32x4 pe = sg_tile<DPLE>((const bf16*)(ws + WS_SMP + SMP_PSB) + (size_t)l * SB * DPLE, (const bf16*)(ws + WS_W + l * W_LAYER + W_PL), t * 64, red1, wave, lane, tid);
                    const int row = tid >> 4, col = t * 64 + (tid & 15) * 4;
                    f32x4 o = *(const f32x4*)(HS + row * D + col);
#pragma unroll
                    for (int e = 0; e < 4; ++e) o[e] += pe[e] * __builtin_amdgcn_rcpf(1.0f + __builtin_amdgcn_exp2f(gt[e]));
                    *(f32x4*)(HS + row * D + col) = o; v2u w; w.x = pk2(o[0], o[1]); w.y = pk2(o[2], o[3]); *(v2u*)(hsby + row * D + col) = w;
                    sss_put((float*)(ws + WS_SMP + SMP_SSS), row, t, o, tid);
                    __syncthreads();
                }
            }
            { unsigned char* ws = KWS();
              pg8::Gemm g{(const bf16*)(ws + WS_PB) + (size_t)l * M * DPLE, (const bf16*)(ws + WS_W + l * W_LAYER + W_PL), M, D, DPLE}; pg8::StaticOrder S; S.init(M, D, G, bx);
              pg8::EpiPlain E{D};
              for (int rep = 0; rep < REP_PE; ++rep)
              pg8::gemm_phase<pg8::EpiPlain, pg8::StaticOrder, false, true>(lds + RING_OFF, g, S, E, wave); }
            { unsigned char* ws = KWS();
              pg8::Gemm g{(const bf16*)(ws + ((l & 1) ? WS_HB1 : WS_HB0)), (const bf16*)(ws + WS_W + l * W_LAYER + W_GT), M, D, D}; pg8::StaticOrder S; S.init(M, D, G, bx);
              for (int rep = 0; rep < REP_P6; ++rep) {
              pg8::EpiGate E{l, rep < REP_P6 - 1};
              pg8::gemm_phase<pg8::EpiGate, pg8::StaticOrder, false, true>(lds + RING_OFF, g, S, E, wave); } }
            SEAM(pb + 5);
        }
}
__global__ void __launch_bounds__(NWAVES * 64, 2) fwd(Args args) {
    extern __shared__ __attribute__((aligned(16))) unsigned char lds_raw[];
    LAS unsigned char* lds = (LAS unsigned char*)lds_raw;
    volatile LAS unsigned* MISC = (volatile LAS unsigned*)(lds + MISC_OFF);
    const int tid0 = threadIdx.x, wave = __builtin_amdgcn_readfirstlane(tid0 >> 6);
    const int G = gridDim.x, bx = blockIdx.x;
    for (int u = tid0; u < (LDS_BYTES - LDSCTL_OFF) / 4; u += NWAVES * 64) ((LAS unsigned*)(lds + LDSCTL_OFF))[u] = 0u;
    __syncthreads();
    const int lo = args.ph_lo, hi = args.ph_hi;
    XcdBarrier bar; bar.bar = nullptr; bar.x = 0; bar.st = MISC + 8;
    if (hi - lo > 1) bar = xcd_barrier_post((unsigned*)(KWS() + WS_CTL) + CW_BAR, MISC + 8);
    LAS float* red0 = (LAS float*)(lds + RING_OFF); LAS float* red1 = (LAS float*)(lds + RING_OFF + 65536);

    if (IN(0)) {
            PH_TID();
        for (int rep = 0; rep < REP_P0; ++rep) {
        const int vcu = (G % 8 == 0) ? (bx % 8) * (G / 8) + bx / 8 : bx;
        const int gw = vcu * NWAVES + wave, NGW = G * NWAVES;
        unsigned char* ws = KWS();
        LAS float* scr = (LAS float*)(lds + RING_OFF + wave * 16384);
        constexpr int I_FOLD = 256, I_IN = 512, I_OUT = 128, I_UP = 1024, I_DN = 1024, I_GT = 256, I_PL = 64, I_REST = I_IN + I_OUT + I_UP + I_DN + I_GT + I_PL;
        { const float* pool_w = KIN(8); const float* pool_scale = KIN(9); const float* w_out = KIN(10);
          for (int it = gw; it < NL * I_FOLD; it += NGW) { const int l = it / I_FOLD, r = it % I_FOLD;
            fold_item(pool_w + (size_t)l * 4 * 128 * 128, pool_scale + l * 512, w_out + (size_t)l * 1024 * 1024, (bf16*)(ws + WS_W + l * W_LAYER + W_OUT), scr, r, lane); } }
        for (int it = gw; it < NL * I_REST; it += NGW) { const int l = it / I_REST; int r = it % I_REST;
            unsigned char* wl = ws + WS_W + l * W_LAYER;
            const float* W; int N; const float* g; bf16* WT; int ldk;
            if (r < I_IN) { W = KIN(7) + (size_t)l * 1024 * 2048; N = 2048; g = KIN(6) + l * 1024; WT = (bf16*)(wl + W_IN); ldk = 1024; }
            else if ((r -= I_IN) < I_OUT) { W = KIN(10) + (size_t)l * 1024 * 1024; N = 1024; g = nullptr; WT = (bf16*)(wl + W_OUT); ldk = 1024; }
            else if ((r -= I_OUT) < I_UP) { W = KIN(12) + (size_t)l * 1024 * 4096; N = 4096; g = KIN(11) + l * 1024; WT = (bf16*)(wl + W_UP); ldk = 1024; }
            else if ((r -= I_UP) < I_DN) { W = KIN(13) + (size_t)l * 4096 * 1024; N = 1024; g = nullptr; WT = (bf16*)(wl + W_DN); ldk = 4096; }
            else if ((r -= I_DN) < I_GT) { W = KIN(15) + (size_t)l * 1024 * 1024; N = 1024; g = KIN(14) + l * 1024; WT = (bf16*)(wl + W_GT); ldk = 1024; }
            else { r -= I_GT; W = KIN(16) + (size_t)l * 256 * 1024; N = 1024; g = nullptr; WT = (bf16*)(wl + W_PL); ldk = 256; }
            tr_item(W, N, g, WT, ldk, r, lane); }
        { const float* x_prompt = KIN(0); bf16* HB0 = (bf16*)(ws + WS_HB0); float* SS_A = (float*)(ws + WS_SS);
          for (int m = gw; m < M; m += NGW) xrow_item(x_prompt + (size_t)m * D, HB0 + (size_t)m * D, SS_A + (size_t)m * 4, 4, nullptr, lane); }
        { const float* p_prompt = KIN(4); bf16* PB = (bf16*)(ws + WS_PB);
          for (int it = gw; it < NL * M * DPLE / 512; it += NGW) cvt_item(p_prompt, PB, it, lane); }
        { const float* x_sample = KIN(1); unsigned char* smp = ws + WS_SMP;
          for (int m = gw; m < SB; m += NGW) xrow_item(x_sample + (size_t)m * D, (bf16*)(smp + SMP_HSB0) + (size_t)m * D, (float*)(smp + SMP_SSS) + m * 16, 16, (float*)(smp + SMP_HS) + (size_t)m * D, lane);
          const float* p_sample = KIN(5);
          for (int it = gw; it < NL * SB * DPLE / 512; it += NGW) cvt_item(p_sample, (bf16*)(smp + SMP_PSB), it, lane); }
        }
        VM_WAIT(); __syncthreads();
        SEAM(0);
    }

    layer_phases<0>(lds, lo, hi, G, bx, wave, bar);
    layer_phases<1>(lds, lo, hi, G, bx, wave, bar);
    layer_phases<2>(lds, lo, hi, G, bx, wave, bar);
    layer_phases<3>(lds, lo, hi, G, bx, wave, bar);
    if (IN(N_PHASES - 1)) {
            PH_TID();
        const int gw = bx * NWAVES + wave, NGW = G * NWAVES;
        unsigned char* ws = KWS(); float* outp = KOUT(); const float* g_final = KIN(17);
        const bf16* HBF = (const bf16*)(ws + ((NL & 1) ? WS_HB1 : WS_HB0)); const float* SS_A = (const float*)(ws + WS_SS);
        for (int m = gw; m < M; m += NGW) final_row_bf(HBF + (size_t)m * D, pg8::row_rstd(SS_A, m), g_final, outp + O_YP + (size_t)m * D, lane);
        for (int m = gw; m < SB; m += NGW) final_row((const float*)(ws + WS_SMP + SMP_HS) + (size_t)m * D, srstd((const float*)(ws + WS_SMP + SMP_SSS), m), g_final, outp + O_YS + (size_t)m * D, lane);
    }
#undef IN
#undef SEAM
}

extern "C" void kernel_launch(void* const* d_in, const int* in_sizes, int n_in, void* d_out, int out_size, void* d_ws, size_t ws_size, hipStream_t stream) {
    static int grid = 0;
    if (grid == 0) {
        if (n_in != 18 || in_sizes[0] != M * D || (size_t)out_size != O_END || ws_size < WS_END) { fprintf(stderr, "kernel_launch: unexpected shapes (n_in %d, in0 %d, out %d, ws %zu); nothing launched\n", n_in, n_in > 0 ? in_sizes[0] : -1, out_size, ws_size); grid = -1; return; }
        int dev = 0, cus = 0, per_cu = 0;
        if (hipGetDevice(&dev) != hipSuccess || hipDeviceGetAttribute(&cus, hipDeviceAttributeMultiprocessorCount, dev) != hipSuccess) { fprintf(stderr, "kernel_launch: device query failed\n"); grid = -1; return; }
        if (hipFuncSetAttribute((const void*)fwd, hipFuncAttributeMaxDynamicSharedMemorySize, LDS_BYTES) != hipSuccess) { fprintf(stderr, "kernel_launch: hipFuncSetAttribute failed\n"); grid = -1; return; }
        if (hipOccupancyMaxActiveBlocksPerMultiprocessor(&per_cu, (const void*)fwd, NWAVES * 64, LDS_BYTES) != hipSuccess || per_cu < 1) fprintf(stderr, "kernel_launch: note: occupancy query reports %d workgroups per CU\n", per_cu);
        (void)hipGetLastError();
        grid = cus;
        if (grid != 256) fprintf(stderr, "kernel_launch: %d CUs: this kernel is built for a 256-CU device\n", grid);
    }
    if (grid < 0) return;
    if (hipMemsetAsync((char*)d_ws + WS_CTL, 0, CTL_ZERO_BYTES, stream) != hipSuccess) { fprintf(stderr, "kernel_launch: memset failed\n"); return; }
    Args a{};
    for (int i = 0; i < 18; ++i) a.in[i] = (const float*)d_in[i];
    a.out = (float*)d_out; a.ws = (unsigned char*)d_ws;
#if MK_SPLIT
    for (int p = 0; p < N_PHASES; ++p) { a.ph_lo = p; a.ph_hi = p + 1; hipLaunchKernelGGL(fwd, dim3(grid), dim3(NWAVES * 64), LDS_BYTES, stream, a); }
#else
    a.ph_lo = 0; a.ph_hi = N_PHASES;
    hipLaunchKernelGGL(fwd, dim3(grid), dim3(NWAVES * 64), LDS_BYTES, stream, a);
#endif
    const hipError_t le = hipPeekAtLastError();
    if (le != hipSuccess) fprintf(stderr, "kernel_launch: launch failed: %s\n", hipGetErrorName(le));
}
```

```cpp
#include <hip/hip_runtime.h>
#include <cstdio>
#include <cstdint>
#ifndef MK_SPLIT
#define MK_SPLIT 0
#endif
constexpr int NWAVES = 8;

constexpr int NL = 4, NB = 2, SEQ = 8192, M = NB * SEQ, D = 1024, DIN = 2048, DFF = 4096, DPLE = 256, SB = 32, WBUF = 2048, PBUF = 15, DP = 512;
constexpr float QSCALE = 0.125f * 1.4426950408889634f;
constexpr int N_PHASES = 2 + 6 * NL;
constexpr size_t O_YP = 0, O_YS = (size_t)M * D, O_KVP = O_YS + (size_t)SB * D, O_KVS = O_KVP + (size_t)NL * NB * WBUF * 1024, O_PP = O_KVS + (size_t)NL * SB * 1024,
                 O_PS = O_PP + (size_t)NL * NB * PBUF * DP, O_END = O_PS + (size_t)NL * SB * PBUF * DP;
static_assert(O_END == 34762752, "d_out size");

constexpr size_t MiB = 1u << 20, KiB = 1u << 10;
constexpr size_t WS_CTL = 0, CTL_ZERO_BYTES = 1 * MiB;
constexpr size_t WS_W = 2 * MiB, W_LAYER = 25 * MiB;
constexpr size_t W_IN = 0, W_OUT = 4 * MiB, W_UP = 6 * MiB, W_DN = 14 * MiB, W_GT = 22 * MiB, W_PL = 24 * MiB;
constexpr size_t WS_HB0 = 104 * MiB, WS_HB1 = 136 * MiB;
constexpr size_t WS_H = 168 * MiB;
constexpr size_t WS_QKVU = 232 * MiB;
constexpr size_t WS_AO = 296 * MiB;
constexpr size_t WS_ACT = 328 * MiB;
constexpr size_t WS_PE = 456 * MiB;
constexpr size_t WS_PB = 488 * MiB;
constexpr size_t WS_OPART = 520 * MiB;
constexpr size_t WS_LSE = 568 * MiB;
constexpr size_t WS_SS = 570 * MiB;
constexpr size_t WS_SMP = 572 * MiB;
constexpr size_t WS_END = 576 * MiB;
constexpr size_t SMP_HS = 0, SMP_HSB0 = 128 * KiB, SMP_HSB1 = 192 * KiB, SMP_QS = 256 * KiB, SMP_AOS = 320 * KiB, SMP_ACTS = 384 * KiB, SMP_PSB = 640 * KiB, SMP_SSS = 704 * KiB;
constexpr int CW_TMO = 0, CW_BAR = 4096;

constexpr int RING_OFF = 0, RING_BYTES = 131072;
constexpr int LDSCTL_OFF = RING_BYTES, MISC_OFF = LDSCTL_OFF + 320;
constexpr int LDS_BYTES = 147456;
static_assert(MISC_OFF + 128 <= LDS_BYTES, "LDS map");

#define GAS __attribute__((address_space(1)))
#define LAS __attribute__((address_space(3)))
typedef unsigned short bf16;
typedef unsigned v4u __attribute__((ext_vector_type(4)));
typedef unsigned v2u __attribute__((ext_vector_type(2)));
typedef float f32x4 __attribute__((ext_vector_type(4)));
typedef float f32x16 __attribute__((ext_vector_type(16)));
typedef short bf16x8 __attribute__((ext_vector_type(8)));
typedef short s16x4 __attribute__((ext_vector_type(4)));
typedef GAS unsigned gu32;
#define LDS_WAIT() asm volatile("s_waitcnt lgkmcnt(0)" ::: "memory")
#define VM_WAIT() asm volatile("s_waitcnt vmcnt(0)" ::: "memory")
__device__ __forceinline__ unsigned f2bf(float f) { unsigned u = __builtin_bit_cast(unsigned, f); return (u + 0x7fffu + ((u >> 16) & 1u)) >> 16; }
__device__ __forceinline__ unsigned pk2(float lo, float hi) { return f2bf(lo) | (f2bf(hi) << 16); }
__device__ __forceinline__ float bflo(unsigned w) { return __uint_as_float(w << 16); }
__device__ __forceinline__ float bfhi(unsigned w) { return __uint_as_float(w & 0xffff0000u); }
__device__ __forceinline__ float wave_sum(float v) {
#pragma unroll
    for (int o = 1; o < 64; o <<= 1) v += __shfl_xor(v, o);
    return v;
}

template <int OFF> __device__ __forceinline__ unsigned long long karg64() {
    unsigned long long v;
    asm volatile("s_load_dwordx2 %0, %1, %2\n\ts_waitcnt lgkmcnt(0)" : "=s"(v) : "s"(__builtin_amdgcn_kernarg_segment_ptr()), "i"(OFF));
    return v;
}
#define KIN(i) ((const float*)(const GAS float*)karg64<8 * (i)>())
#define KOUT() ((float*)(GAS float*)karg64<144>())
#define KWS() ((unsigned char*)(GAS unsigned char*)karg64<152>())

namespace pg8 {
#define PG8_LAS __attribute__((address_space(3)))
typedef unsigned short bf16_t;
typedef short bf16x8 __attribute__((ext_vector_type(8)));
typedef float f32x4 __attribute__((ext_vector_type(4)));
typedef unsigned u32x4 __attribute__((ext_vector_type(4)));
constexpr int BM = 256, BK = 64, HALF = 128, HTB = HALF * BK * 2  , STAGE_BYTES = 8 * HTB, NXCD = 8, WGM = 8;

__host__ __device__ __forceinline__ int lds_byte(int r, int c) { const int st = (r >> 4) * 2 + (c >> 5), rr = r & 15, cc = c & 31, ob = rr * 64 + cc * 2; return st * 1024 + (ob ^ (((ob >> 9) & 1) << 5)); }
__host__ __device__ __forceinline__ void stage_rc(int b, int& R, int& C) { const int st = b / 1024, sb = b % 1024, swz = sb ^ (((sb >> 9) & 1) << 5); R = (st >> 1) * 16 + swz / 64; C = (st & 1) * 32 + (swz % 64) / 2; }
__host__ __device__ __forceinline__ int perm32(int rho) { const int n = rho >> 4, i = rho & 15; return 8 * (i >> 2) + 4 * n + (i & 3); }

struct Unit { int pm, pn; };
struct Gemm { const bf16_t* A; const bf16_t* Bt; int M, N, K; };

struct StaticOrder {
    int nM, nN, nwg, G, c;
    __host__ __device__ void init(int M, int N, int G_, int c_) { nM = M / BM; nN = N / BM; nwg = nM * nN; G = G_; c = c_; }
    __host__ __device__ bool next(int i, Unit& u) const {
        const long L = (long)i * G + c; if (L >= nwg) return false;
        int wgid = (int)L; { const int q = nwg / NXCD, r = nwg % NXCD, xcd = wgid % NXCD, off = wgid / NXCD; wgid = (xcd < r ? xcd * (q + 1) : r * (q + 1) + (xcd - r) * q) + off; }
        const int nig = WGM * nN, gid = wgid / nig, fm = gid * WGM, gsz = (nM - fm) < WGM ? (nM - fm) : WGM;
        u.pm = fm + ((wgid % nig) % gsz); u.pn = (wgid % nig) / gsz; return true;
    }
    __device__ __forceinline__ void a_ready(const Unit&) const {}
    __device__ __forceinline__ void done(const Unit&) const {}
};

__device__ __forceinline__ unsigned cvt_pk_bf16(float lo, float hi) { unsigned r; asm volatile("v_cvt_pk_bf16_f32 %0, %1, %2" : "=v"(r) : "v"(lo), "v"(hi)); return r; }
typedef float f32x2 __attribute__((ext_vector_type(2)));
typedef unsigned u32x2 __attribute__((ext_vector_type(2)));
__device__ __forceinline__ u32x4 pack8(const f32x4 a, const f32x4 b) { u32x4 w; w.x = cvt_pk_bf16(a[0], a[1]); w.y = cvt_pk_bf16(a[2], a[3]); w.z = cvt_pk_bf16(b[0], b[1]); w.w = cvt_pk_bf16(b[2], b[3]); return w; }
__device__ __forceinline__ float dot4(const f32x4 a) { return (a[0] * a[0] + a[1] * a[1]) + (a[2] * a[2] + a[3] * a[3]); }
__device__ __forceinline__ float row_rstd(const float* ss, int row) { const f32x4 s = *(const f32x4*)(ss + (size_t)row * 4); return __builtin_amdgcn_rsqf(((s[0] + s[1]) + (s[2] + s[3])) * (1.0f / 1024.0f) + 1e-6f); }
__device__ __forceinline__ void unpack8(const u32x4 w, f32x4& a, f32x4& b) {
    a[0] = __uint_as_float(w.x << 16); a[1] = __uint_as_float(w.x & 0xffff0000u); a[2] = __uint_as_float(w.y << 16); a[3] = __uint_as_float(w.y & 0xffff0000u);
    b[0] = __uint_as_float(w.z << 16); b[1] = __uint_as_float(w.z & 0xffff0000u); b[2] = __uint_as_float(w.w << 16); b[3] = __uint_as_float(w.w & 0xffff0000u); }

struct EpiPlain {
    static constexpr bool PERM = true, AFTER_DRAIN = false;
    int ldc;
    __device__ __forceinline__ void operator()(const f32x4 (&acc)[2][2][4][2], const Unit& u, int wr, int wc, int fr, int fq) const {
        asm volatile("" : "+v"(fr), "+v"(fq));
        bf16_t* O = (bf16_t*)(KWS() + WS_PE);
        const int row0 = u.pm * BM + wr * 64 + fr, col0 = u.pn * BM + wc * 32 + 8 * fq;
#pragma unroll
        for (int ai = 0; ai < 2; ++ai)
#pragma unroll
            for (int m = 0; m < 4; ++m) { bf16_t* rowp = O + (size_t)(row0 + ai * HALF + m * 16) * ldc + col0;
#pragma unroll
                for (int bj = 0; bj < 2; ++bj) *(u32x4*)(rowp + bj * HALF) = pack8(acc[ai][bj][m][0], acc[ai][bj][m][1]); }
    }
};
struct EpiProj {
    static constexpr bool PERM = true, AFTER_DRAIN = false;
    int l;
    __device__ __forceinline__ void operator()(const f32x4 (&acc)[2][2][4][2], const Unit& u, int wr, int wc, int fr, int fq) const {
        asm volatile("" : "+v"(fr), "+v"(fq));
        unsigned char* ws = KWS(); float* outp = KOUT();
        bf16_t* O = (bf16_t*)(ws + WS_QKVU); const float* ss = (const float*)(ws + WS_SS);
        float* kv_out = outp + O_KVP + (size_t)l * NB * WBUF * 1024; float* pool_out = outp + O_PP + (size_t)l * NB * PBUF * DP;
        const int row0 = u.pm * BM + wr * 64 + fr, col0 = u.pn * BM + wc * 32 + 8 * fq;
        const float sc = (u.pn < 2) ? QSCALE : 1.0f;
        const int b = u.pm >> 5, t0 = (u.pm & 31) * BM + wr * 64 + fr;
        const bool kvt = (u.pn >= 2) && (u.pn < 6) && ((u.pm & 31) >= 24);
        const bool plt = (u.pn >= 6) && ((u.pm & 31) == 31);
#pragma unroll
        for (int ai = 0; ai < 2; ++ai)
#pragma unroll
            for (int m = 0; m < 4; ++m) { const int row = row0 + ai * HALF + m * 16, t = t0 + ai * HALF + m * 16;
                const float rs = row_rstd(ss, row);
#pragma unroll
                for (int bj = 0; bj < 2; ++bj) { const int col = col0 + bj * HALF;
                    const f32x4 v0 = acc[ai][bj][m][0] * rs, v1 = acc[ai][bj][m][1] * rs;
                    *(u32x4*)(O + (size_t)row * 2048 + col) = pack8(v0 * sc, v1 * sc);
                    if (kvt) { float* p = kv_out + ((size_t)(b * 2048 + (t - 6144)) * 1024 + (col - 512)); *(f32x4*)p = v0; *(f32x4*)(p + 4) = v1; }
                    if (plt && t >= 8177) { float* p = pool_out + ((size_t)(b * 15 + (t - 8177)) * 512 + (col - 1536)); *(f32x4*)p = v0; *(f32x4*)(p + 4) = v1; } } }
    }
};
struct EpiUp {
    static constexpr bool PERM = true, AFTER_DRAIN = false;
    int l;
    __device__ __forceinline__ void operator()(const f32x4 (&acc)[2][2][4][2], const Unit& u, int wr, int wc, int fr, int fq) const {
        asm volatile("" : "+v"(fr), "+v"(fq));
        unsigned char* ws = KWS();
        bf16_t* O = (bf16_t*)(ws + WS_ACT); const float* ss = (const float*)(ws + WS_SS) + (size_t)M * 4;
        const int row0 = u.pm * BM + wr * 64 + fr, col0 = u.pn * BM + wc * 32 + 8 * fq;
#pragma unroll
        for (int ai = 0; ai < 2; ++ai)
#pragma unroll
            for (int m = 0; m < 4; ++m) { const int row = row0 + ai * HALF + m * 16;
                const float rs = row_rstd(ss, row);
#pragma unroll
                for (int bj = 0; bj < 2; ++bj) {
                    f32x4 v0 = acc[ai][bj][m][0] * rs, v1 = acc[ai][bj][m][1] * rs;
#pragma unroll
                    for (int e = 0; e < 4; ++e) { const float a = fmaxf(v0[e], 0.f), c = fmaxf(v1[e], 0.f); v0[e] = a * a; v1[e] = c * c; }
                    const u32x4 pk = pack8(v0, v1);
#ifdef REP_EPI4
                    for (int rep = 0; rep < REP_EPI4; ++rep) { asm volatile("" ::: "memory"); *(u32x4*)(O + (size_t)row * 4096 + col0 + bj * HALF) = pk; }
#else
                    *(u32x4*)(O + (size_t)row * 4096 + col0 + bj * HALF) = pk;
#endif
                    } }
    }
};
__device__ __forceinline__ void ss_finish(PG8_LAS unsigned char* lds, float* ssout, const Unit& u) {
    asm volatile("s_waitcnt lgkmcnt(0)" ::: "memory"); __builtin_amdgcn_s_barrier(); asm volatile("" ::: "memory");
    if (threadIdx.x < 256) { const f32x4 p = *(const PG8_LAS f32x4*)(lds + threadIdx.x * 16); ssout[(size_t)(u.pm * BM + threadIdx.x) * 4 + u.pn] = (p[0] + p[1]) + (p[2] + p[3]); }
}
struct EpiRes {
    static constexpr bool PERM = true, AFTER_DRAIN = true;
    int l, which, dummy;
    __device__ __forceinline__ void fused(f32x4 (&acc)[2][2][4][2], const Unit& u, int wr, int wc, int fr, int fq, PG8_LAS unsigned char* lds, int wid, int lane) const {
        asm volatile("" : "+v"(fr), "+v"(fq));
        unsigned char* ws = KWS();
        const bf16_t* base = (const bf16_t*)(ws + ((l & 1) ? WS_HB1 : WS_HB0)); bf16_t* hb = dummy ? (bf16_t*)(ws + WS_H) : (bf16_t*)(ws + ((l & 1) ? WS_HB1 : WS_HB0));
        float* ssout = (float*)(ws + WS_SS) + (size_t)(1 + which) * M * 4;
        PG8_LAS float* P = (PG8_LAS float*)lds;
        const int row0 = u.pm * BM + wr * 64 + fr, col0 = u.pn * BM + wc * 32 + 8 * fq;
#pragma unroll
        for (int ai = 0; ai < 2; ++ai)
#pragma unroll
            for (int m = 0; m < 4; ++m) { const size_t off = (size_t)(row0 + ai * HALF + m * 16) * 1024 + col0; float q = 0.f;
#pragma unroll
                for (int bj = 0; bj < 2; ++bj) {
                    f32x4 b0, b1; unpack8(*(const u32x4*)(base + off + bj * HALF), b0, b1);
                    const f32x4 o0 = b0 + acc[ai][bj][m][0], o1 = b1 + acc[ai][bj][m][1];
                    *(u32x4*)(hb + off + bj * HALF) = pack8(o0, o1);
                    q += dot4(o0) + dot4(o1); }
                q += __shfl_xor(q, 16); q += __shfl_xor(q, 32);
                if (fq == 0) P[(ai * HALF + wr * 64 + m * 16 + fr) * 4 + wc] = q; }
        ss_finish(lds, ssout, u);
    }
};
struct EpiGate {
    static constexpr bool PERM = true, AFTER_DRAIN = true;
    int l, dummy;
    __device__ __forceinline__ void fused(f32x4 (&acc)[2][2][4][2], const Unit& u, int wr, int wc, int fr, int fq, PG8_LAS unsigned char* lds, int wid, int lane) const {
        asm volatile("" : "+v"(fr), "+v"(fq));
        unsigned char* ws = KWS();
        const bf16_t* base = (const bf16_t*)(ws + ((l & 1) ? WS_HB1 : WS_HB0)); bf16_t* hb = dummy ? (bf16_t*)(ws + WS_H) : (bf16_t*)(ws + ((l & 1) ? WS_HB0 : WS_HB1)); const bf16_t* pe = (const bf16_t*)(ws + WS_PE);
        const float* ssin = (const float*)(ws + WS_SS) + (size_t)2 * M * 4; float* ssout = (float*)(ws + WS_SS);
        PG8_LAS float* P = (PG8_LAS float*)lds;
        const int row0 = u.pm * BM + wr * 64 + fr, col0 = u.pn * BM + wc * 32 + 8 * fq;
#pragma unroll
        for (int ai = 0; ai < 2; ++ai)
#pragma unroll
            for (int m = 0; m < 4; ++m) { const int row = row0 + ai * HALF + m * 16; const size_t off = (size_t)row * 1024 + col0; float q = 0.f;
                const float rs = row_rstd(ssin, row);
#pragma unroll
                for (int bj = 0; bj < 2; ++bj) {
                    f32x4 p0, p1, b0, b1; unpack8(*(const u32x4*)(pe + off + bj * HALF), p0, p1); unpack8(*(const u32x4*)(base + off + bj * HALF), b0, b1);
                    f32x4 g0 = acc[ai][bj][m][0] * (rs * -1.4426950408889634f), g1 = acc[ai][bj][m][1] * (rs * -1.4426950408889634f);
#pragma unroll
                    for (int e = 0; e < 4; ++e) { g0[e] = __builtin_amdgcn_rcpf(1.0f + __builtin_amdgcn_exp2f(g0[e])); g1[e] = __builtin_amdgcn_rcpf(1.0f + __builtin_amdgcn_exp2f(g1[e])); }
                    const f32x4 o0 = b0 + p0 * g0, o1 = b1 + p1 * g1;
                    *(u32x4*)(hb + off + bj * HALF) = pack8(o0, o1);
                    q += dot4(o0) + dot4(o1); }
                q += __shfl_xor(q, 16); q += __shfl_xor(q, 32);
                if (fq == 0) P[(ai * HALF + wr * 64 + m * 16 + fr) * 4 + wc] = q; }
        ss_finish(lds, ssout, u);
    }
};

template <class Epi, class Sched, bool ALIGN_EPI = false, bool SP2 = false>
__device__ __forceinline__ void gemm_phase(PG8_LAS unsigned char* lds, const Gemm g, const Sched& S, const Epi& E, int wave_id) {
    int lane = (int)__builtin_amdgcn_mbcnt_hi(~0u, __builtin_amdgcn_mbcnt_lo(~0u, 0u)), widv = wave_id; asm volatile("" : "+v"(lane), "+v"(widv)); const int wid = __builtin_amdgcn_readfirstlane(widv);
    const int tid = wid * 64 + lane, wr = wid >> 2, wc = wid & 3, fr = lane & 15, fq = lane >> 4;
    const int K = g.K, nt = K / BK;
    unsigned voffA[2], voffB[2];
#pragma unroll
    for (int i = 0; i < 2; ++i) { int R, C; stage_rc(tid * 16 + i * 8192, R, C); const int Rb = Epi::PERM ? ((R & ~31) + perm32(R & 31)) : R;
        voffA[i] = (unsigned)(R * K + C) * 2u; voffB[i] = (unsigned)(Rb * K + C) * 2u; }
    const size_t kstep = (size_t)(BK * 2);
    const size_t hstep = (size_t)HALF * K * 2;
    const size_t tstep = 2 * hstep;
    const unsigned ldsw = (unsigned)wid * 1024u;
    const int aoff = lds_byte(wr * 64 + fr, fq * 8), boff = lds_byte(wc * 32 + fr, fq * 8);
#define PG8_SA(b, h) (((b) * 2 + (h)) * HTB)
#define PG8_SB(b, h) ((4 + (b) * 2 + (h)) * HTB)
#define PG8_STAGE(bufoff, gbase, voff) do { _Pragma("unroll") for (int _i = 0; _i < 2; ++_i) \
        __builtin_amdgcn_global_load_lds((const unsigned*)((const char*)(gbase) + (voff)[_i]), (PG8_LAS unsigned*)(lds + (bufoff) + ldsw + _i * 8192), 16, 0, 0); } while (0)
#define PG8_LDA(dst, b, h) do { _Pragma("unroll") for (int m = 0; m < 4; ++m) _Pragma("unroll") for (int k = 0; k < 2; ++k) dst[m][k] = *(const PG8_LAS bf16x8*)(lds + PG8_SA(b, h) + aoff + m * 2048 + k * 1024); } while (0)
#define PG8_LDB(dst, b, h) do { _Pragma("unroll") for (int n = 0; n < 2; ++n) _Pragma("unroll") for (int k = 0; k < 2; ++k) dst[n][k] = *(const PG8_LAS bf16x8*)(lds + PG8_SB(b, h) + boff + n * 2048 + k * 1024); } while (0)
#define PG8_MMA(ai, bj, At, Bt) do { __builtin_amdgcn_s_setprio(1); _Pragma("unroll") for (int m = 0; m < 4; ++m) _Pragma("unroll") for (int n = 0; n < 2; ++n) _Pragma("unroll") for (int k = 0; k < 2; ++k) \
        acc[ai][bj][m][n] = __builtin_amdgcn_mfma_f32_16x16x32_bf16(Bt[n][k], At[m][k], acc[ai][bj][m][n], 0, 0, 0); __builtin_amdgcn_s_setprio(0); } while (0)
#define PG8_WAIT_V(n) asm volatile("s_waitcnt vmcnt(" #n ")" ::: "memory")
#define PG8_WAIT_L(n) asm volatile("s_waitcnt lgkmcnt(" #n ")" ::: "memory")
#define PG8_BAR __builtin_amdgcn_s_barrier()
#define PG8_SCHED __builtin_amdgcn_sched_barrier(0)
    Unit cur, nxt; int ui = 0;
    if (!S.next(0, cur)) return;
    f32x4 acc[2][2][4][2];
#pragma unroll
    for (int a = 0; a < 2; ++a)
#pragma unroll
        for (int b = 0; b < 2; ++b)
#pragma unroll
            for (int m = 0; m < 4; ++m)
#pragma unroll
                for (int n = 0; n < 2; ++n) acc[a][b][m][n] = (f32x4){0.f, 0.f, 0.f, 0.f};
    bf16x8 At[4][2], B0[2][2], B1[2][2];
    const char* cA = (const char*)g.A + (size_t)cur.pm * tstep; const char* cB = (const char*)g.Bt + (size_t)cur.pn * tstep;
    S.a_ready(cur);
    if constexpr (SP2) {
        PG8_STAGE(PG8_SB(0, 0), cB, voffB); PG8_STAGE(PG8_SB(0, 1), cB + hstep, voffB); PG8_STAGE(PG8_SA(0, 0), cA, voffA); PG8_STAGE(PG8_SA(0, 1), cA + hstep, voffA);
        if (wr == 1) PG8_BAR;
        PG8_WAIT_V(2); PG8_BAR;
        PG8_STAGE(PG8_SB(1, 0), cB + kstep, voffB); PG8_STAGE(PG8_SA(1, 0), cA + kstep, voffA); PG8_STAGE(PG8_SB(1, 1), cB + hstep + kstep, voffB);
        PG8_WAIT_V(6); PG8_BAR;
    } else {
        PG8_STAGE(PG8_SB(0, 0), cB, voffB); PG8_STAGE(PG8_SA(0, 0), cA, voffA); PG8_STAGE(PG8_SB(0, 1), cB + hstep, voffB); PG8_STAGE(PG8_SA(0, 1), cA + hstep, voffA);
        if (wr == 1) PG8_BAR;
        PG8_WAIT_V(4); PG8_BAR;
        PG8_STAGE(PG8_SB(1, 0), cB + kstep, voffB); PG8_STAGE(PG8_SA(1, 0), cA + kstep, voffA); PG8_STAGE(PG8_SB(1, 1), cB + hstep + kstep, voffB);
        PG8_WAIT_V(6); PG8_BAR;
    }
    for (;;) {
        const bool has_next = S.next(ui + 1, nxt);
        const char* nA = has_next ? (const char*)g.A + (size_t)nxt.pm * tstep : cA; const char* nB = has_next ? (const char*)g.Bt + (size_t)nxt.pn * tstep : cB;
        for (int t = 0; t < nt; t += 2) {
            const bool last = (t == nt - 2);
            const char* a1 = cA + (size_t)(t + 1) * kstep;
            const char* a2 = last ? nA : cA + (size_t)(t + 2) * kstep; const char* b2 = last ? nB : cB + (size_t)(t + 2) * kstep;
            const char* a3 = a2 + kstep; const char* b3 = b2 + kstep;
            if (last && has_next) S.a_ready(nxt);
            if constexpr (SP2) {
            PG8_LDB(B0, 0, 0); PG8_LDB(B1, 0, 1); PG8_SCHED; PG8_LDA(At, 0, 0); PG8_STAGE(PG8_SA(1, 1), a1 + hstep, voffA);
            PG8_WAIT_V(8); PG8_WAIT_L(0); PG8_BAR; PG8_MMA(0, 0, At, B0); PG8_MMA(0, 1, At, B1); PG8_BAR; PG8_SCHED;
            PG8_LDA(At, 0, 1); PG8_STAGE(PG8_SB(0, 0), b2, voffB); PG8_STAGE(PG8_SB(0, 1), b2 + hstep, voffB); PG8_STAGE(PG8_SA(0, 0), a2, voffA);
            PG8_WAIT_V(8); PG8_WAIT_L(0); PG8_BAR; PG8_MMA(1, 0, At, B0); PG8_MMA(1, 1, At, B1); PG8_BAR; PG8_SCHED;
            PG8_LDB(B0, 1, 0); PG8_LDB(B1, 1, 1); PG8_SCHED; PG8_LDA(At, 1, 0); PG8_STAGE(PG8_SA(0, 1), a2 + hstep, voffA);
            PG8_WAIT_V(8); PG8_WAIT_L(0); PG8_BAR; PG8_MMA(0, 0, At, B0); PG8_MMA(0, 1, At, B1); PG8_BAR; PG8_SCHED;
            PG8_LDA(At, 1, 1); PG8_STAGE(PG8_SB(1, 0), b3, voffB); PG8_STAGE(PG8_SB(1, 1), b3 + hstep, voffB); PG8_STAGE(PG8_SA(1, 0), a3, voffA);
            PG8_WAIT_V(8); PG8_WAIT_L(0); PG8_BAR; PG8_MMA(1, 0, At, B0); PG8_MMA(1, 1, At, B1); PG8_BAR; PG8_SCHED;
            } else {
            PG8_LDB(B0, 0, 0); PG8_SCHED; PG8_LDA(At, 0, 0); PG8_STAGE(PG8_SA(1, 1), a1 + hstep, voffA);
            PG8_WAIT_L(8); PG8_BAR; PG8_WAIT_L(0); PG8_MMA(0, 0, At, B0); PG8_BAR; PG8_SCHED;
            PG8_LDB(B1, 0, 1); PG8_STAGE(PG8_SB(0, 0), b2, voffB);
            PG8_BAR; PG8_WAIT_L(0); PG8_MMA(0, 1, At, B1); PG8_BAR;
            PG8_LDA(At, 0, 1); PG8_STAGE(PG8_SA(0, 0), a2, voffA);
            PG8_BAR; PG8_WAIT_L(0); PG8_MMA(1, 0, At, B0); PG8_BAR; PG8_SCHED;
            PG8_STAGE(PG8_SB(0, 1), b2 + hstep, voffB);
            PG8_WAIT_V(6); PG8_BAR; PG8_MMA(1, 1, At, B1); PG8_BAR;
            PG8_LDB(B0, 1, 0); PG8_SCHED; PG8_LDA(At, 1, 0); PG8_STAGE(PG8_SA(0, 1), a2 + hstep, voffA);
            PG8_WAIT_L(8); PG8_BAR; PG8_WAIT_L(0); PG8_MMA(0, 0, At, B0); PG8_BAR; PG8_SCHED;
            PG8_LDB(B1, 1, 1); PG8_STAGE(PG8_SB(1, 0), b3, voffB);
            PG8_BAR; PG8_WAIT_L(0); PG8_MMA(0, 1, At, B1); PG8_BAR;
            PG8_LDA(At, 1, 1); PG8_STAGE(PG8_SA(1, 0), a3, voffA);
            PG8_BAR; PG8_WAIT_L(0); PG8_MMA(1, 0, At, B0); PG8_BAR; PG8_SCHED;
            PG8_STAGE(PG8_SB(1, 1), b3 + hstep, voffB);
            PG8_WAIT_V(6); PG8_BAR; PG8_MMA(1, 1, At, B1); PG8_BAR;
            }
        }
        if constexpr (ALIGN_EPI) { if (wr == 0) PG8_BAR; }
        if constexpr (!Epi::AFTER_DRAIN) { E(acc, cur, wr, wc, fr, fq); S.done(cur); }
        if (!has_next) break;
#pragma unroll
        for (int a = 0; a < 2; ++a)
#pragma unroll
            for (int b = 0; b < 2; ++b)
#pragma unroll
                for (int m = 0; m < 4; ++m)
#pragma unroll
                    for (int n = 0; n < 2; ++n) acc[a][b][m][n] = (f32x4){0.f, 0.f, 0.f, 0.f};
        cur = nxt; cA = nA; cB = nB; ++ui;
        if constexpr (ALIGN_EPI) { if (wr == 1) PG8_BAR; }
    }
    PG8_WAIT_V(0);
    if constexpr (!ALIGN_EPI) { if (wr == 0) PG8_BAR; }
    PG8_BAR;
    if constexpr (Epi::AFTER_DRAIN) { E.fused(acc, cur, wr, wc, fr, fq, lds, wid, lane); S.done(cur); }
#undef PG8_SA
#undef PG8_SB
#undef PG8_STAGE
#undef PG8_LDA
#undef PG8_LDB
#undef PG8_MMA
#undef PG8_WAIT_V
#undef PG8_WAIT_L
#undef PG8_BAR
#undef PG8_SCHED
}
}
#define XB_TMO      128
#define XB_XCNT(j)  (256  + 64 * (j))
#define XB_XSUB(j)  (1280 + 64 * (j))
#define XB_XGEN(j)  (2304 + 64 * (j))
#define XB_TOP      3328
#define XB_TOPGEN   3392
#define XCD_BAR_WORDS 3456
#define XB_SPIN_CAP (1u << 18)

__device__ __forceinline__ unsigned xb_ld(unsigned* p)              { return __hip_atomic_load(p, __ATOMIC_RELAXED, __HIP_MEMORY_SCOPE_AGENT); }
__device__ __forceinline__ unsigned xb_add(unsigned* p, unsigned v) { return __hip_atomic_fetch_add(p, v, __ATOMIC_RELAXED, __HIP_MEMORY_SCOPE_AGENT); }
__device__ __forceinline__ unsigned xb_xcc_id() { return (unsigned)__builtin_amdgcn_s_getreg((3 << 11) | 20) & 0xFu; }
#define XB_SPIN(cond, bar) do { unsigned _sp = 0; while (cond) { __builtin_amdgcn_s_sleep(1); \
    if ((++_sp & 255u) == 0u) { if (xb_ld(&(bar)[XB_TMO])) break; if (_sp > XB_SPIN_CAP) { atomicAdd(&(bar)[XB_TMO], 1u); break; } } } } while (0)

struct XcdBarrier {
    unsigned* bar; unsigned x;
    volatile LAS unsigned* st;
};

__device__ __forceinline__ XcdBarrier xcd_barrier_post(unsigned* bar, volatile LAS unsigned* st) {
    XcdBarrier b; b.bar = bar; b.x = xb_xcc_id(); b.st = st;
    if (threadIdx.x == 0) (void)xb_add(&bar[XB_XCNT(b.x)], 1u);
    return b;
}
__device__ __forceinline__ void xcd_barrier_complete(unsigned* bar, unsigned x, unsigned& nloc, unsigned& nx) {
    const unsigned G = gridDim.x * gridDim.y * gridDim.z;
    unsigned sum, cnt, mine, sp = 0u;
    for (;;) {
        sum = 0u; cnt = 0u; mine = 0u;
#pragma unroll
        for (unsigned j = 0; j < 16; ++j) { const unsigned c = xb_ld(&bar[XB_XCNT(j)]); sum += c; cnt += (c > 0u) ? 1u : 0u; mine = (j == x) ? c : mine; }
        if (sum == G) break;
        __builtin_amdgcn_s_sleep(1);
        if ((++sp & 255u) == 0u) { if (xb_ld(&bar[XB_TMO])) break; if (sp > XB_SPIN_CAP) { atomicAdd(&bar[XB_TMO], 1u); break; } }
    }
    nloc = mine > 0u ? mine : 1u; nx = cnt > 0u ? cnt : 1u;
}

__device__ __forceinline__ void xcd_barrier(const XcdBarrier& b) {
    asm volatile("s_waitcnt vmcnt(0)" ::: "memory");
    __syncthreads();
    if (threadIdx.x == 0) {
        unsigned* bar = b.bar;
        __builtin_amdgcn_s_waitcnt(0);
        unsigned nloc = b.st[0], nx = b.st[1];
        if (nloc == 0u) { xcd_barrier_complete(bar, b.x, nloc, nx); b.st[0] = nloc; b.st[1] = nx; }
        const unsigned old = xb_add(&bar[XB_XSUB(b.x)], 1u);
        const unsigned gen = old / nloc;
        if (old + 1u == (gen + 1u) * nloc) {
            __builtin_amdgcn_fence(__ATOMIC_RELEASE, "agent");
            asm volatile("s_waitcnt vmcnt(0)" ::: "memory");
            const unsigned og = xb_add(&bar[XB_TOP], 1u);
            const unsigned tg = og / nx;
            if (og + 1u == (tg + 1u) * nx) xb_add(&bar[XB_TOPGEN], 1u);
            else XB_SPIN(xb_ld(&bar[XB_TOPGEN]) == tg, bar);
            __builtin_amdgcn_fence(__ATOMIC_ACQUIRE, "agent");
            xb_add(&bar[XB_XGEN(b.x)], 1u);
            asm volatile("s_waitcnt vmcnt(0)" ::: "memory");
        } else {
            XB_SPIN(xb_ld(&bar[XB_XGEN(b.x)]) == gen, bar);
            __builtin_amdgcn_fence(__ATOMIC_ACQUIRE, "agent");
            asm volatile("s_waitcnt vmcnt(0)" ::: "memory");
        }
    }
    __syncthreads();
}

__device__ __forceinline__ void tr_item(const float* __restrict__ W, int N, const float* __restrict__ g, bf16* __restrict__ WT, int ldk, LAS float* scr, int item, int lane) {
    const int nblk = N >> 5, kb = item / nblk, nb = item - kb * nblk, k0 = kb << 6, n0 = nb << 5;
    const float* src = W + (size_t)(k0 + (lane >> 5)) * N + n0 + (lane & 31);
    float v[32];
#pragma unroll
    for (int i = 0; i < 32; ++i) v[i] = src[(size_t)(2 * i) * N];
    if (g) {
#pragma unroll
        for (int i = 0; i < 32; ++i) v[i] *= g[k0 + 2 * i + (lane >> 5)];
    }
#pragma unroll
    for (int i = 0; i < 32; ++i) scr[(2 * i + (lane >> 5)) * 33 + (lane & 31)] = v[i];
    LDS_WAIT(); asm volatile("" ::: "memory");
    const int c = lane & 7;
#pragma unroll
    for (int j = 0; j < 4; ++j) { const int n = (lane >> 3) + 8 * j; const LAS float* s = scr + (8 * c) * 33 + n;
        v4u o; o.x = pk2(s[0 * 33], s[1 * 33]); o.y = pk2(s[2 * 33], s[3 * 33]); o.z = pk2(s[4 * 33], s[5 * 33]); o.w = pk2(s[6 * 33], s[7 * 33]);
        *(v4u*)(WT + (size_t)(n0 + n) * ldk + k0 + 8 * c) = o; }
    LDS_WAIT(); asm volatile("" ::: "memory");
}
__device__ __forceinline__ void fold_item(const float* __restrict__ pw, const float* __restrict__ scale, const float* __restrict__ wout, bf16* __restrict__ WT, LAS float* scr, int item, int lane) {
    const int kb = item >> 4, nb = item & 15, kp0 = kb << 5, g = kp0 >> 7, c0 = kp0 & 127, n = (nb << 6) + lane;
    const f32x4* psrc = (const f32x4*)(pw + (size_t)(g * 128 + c0) * 128);
#pragma unroll
    for (int i = 0; i < 16; ++i) *(LAS f32x4*)(scr + (i * 64 + lane) * 4) = psrc[i * 64 + lane];
    LDS_WAIT(); asm volatile("" ::: "memory");
    const float* wsrc = wout + (size_t)(512 + g * 128) * 1024 + n;
    const float* ssrc = scale + g * 128;
    float acc[32];
#pragma unroll
    for (int i = 0; i < 32; ++i) acc[i] = 0.f;
    for (int d4 = 0; d4 < 32; ++d4) {
        const f32x4 s4 = *(const f32x4*)(ssrc + 4 * d4);
        const float v0 = wsrc[(size_t)(4 * d4 + 0) * 1024] * s4[0], v1 = wsrc[(size_t)(4 * d4 + 1) * 1024] * s4[1], v2 = wsrc[(size_t)(4 * d4 + 2) * 1024] * s4[2], v3 = wsrc[(size_t)(4 * d4 + 3) * 1024] * s4[3];
#pragma unroll
        for (int i = 0; i < 32; ++i) { const f32x4 p = *(const LAS f32x4*)(scr + i * 128 + 4 * d4); acc[i] += (p[0] * v0 + p[1] * v1) + (p[2] * v2 + p[3] * v3); }
    }
    v4u* dst = (v4u*)(WT + (size_t)n * 1024 + 512 + kp0);
#pragma unroll
    for (int j = 0; j < 4; ++j) { v4u o; o.x = pk2(acc[8 * j], acc[8 * j + 1]); o.y = pk2(acc[8 * j + 2], acc[8 * j + 3]); o.z = pk2(acc[8 * j + 4], acc[8 * j + 5]); o.w = pk2(acc[8 * j + 6], acc[8 * j + 7]); dst[j] = o; }
    LDS_WAIT(); asm volatile("" ::: "memory");
}
__device__ __forceinline__ void xrow_item(const float* __restrict__ xrow, bf16* __restrict__ orow, float* __restrict__ ssrow, int nss, float* __restrict__ copy, int lane) {
    const f32x4* xr = (const f32x4*)xrow + lane;
    f32x4 v[4]; float s = 0.f;
#pragma unroll
    for (int j = 0; j < 4; ++j) { v[j] = xr[64 * j]; s += (v[j][0] * v[j][0] + v[j][1] * v[j][1]) + (v[j][2] * v[j][2] + v[j][3] * v[j][3]); }
    s = wave_sum(s);
    v2u* o8 = (v2u*)orow + lane;
#pragma unroll
    for (int j = 0; j < 4; ++j) { v2u o; o.x = pk2(v[j][0], v[j][1]); o.y = pk2(v[j][2], v[j][3]); o8[64 * j] = o; }
    if (copy) {
#pragma unroll
        for (int j = 0; j < 4; ++j) ((f32x4*)copy + lane)[64 * j] = v[j];
    }
    if (lane < nss) ssrow[lane] = (lane == 0) ? s : 0.f;
}
__device__ __forceinline__ void xrow2_item(const float* __restrict__ xrow, bf16* __restrict__ orow, float* __restrict__ ssrow, size_t dr, int lane) {
    f32x4 v[2][4]; float s[2] = {0.f, 0.f};
#pragma unroll
    for (int r = 0; r < 2; ++r)
#pragma unroll
        for (int j = 0; j < 4; ++j) v[r][j] = ((const f32x4*)(xrow + r * dr * D) + lane)[64 * j];
#pragma unroll
    for (int r = 0; r < 2; ++r) {
#pragma unroll
        for (int j = 0; j < 4; ++j) s[r] += (v[r][j][0] * v[r][j][0] + v[r][j][1] * v[r][j][1]) + (v[r][j][2] * v[r][j][2] + v[r][j][3] * v[r][j][3]);
        s[r] = wave_sum(s[r]);
        v2u* o8 = (v2u*)(orow + r * dr * D) + lane;
#pragma unroll
        for (int j = 0; j < 4; ++j) { v2u o; o.x = pk2(v[r][j][0], v[r][j][1]); o.y = pk2(v[r][j][2], v[r][j][3]); o8[64 * j] = o; }
        if (lane < 4) ssrow[r * dr * 4 + lane] = (lane == 0) ? s[r] : 0.f;
    }
}
__device__ __forceinline__ void cvt_item4(const float* __restrict__ src, bf16* __restrict__ dst, int item, int lane) {
    const size_t idx = (size_t)item * 2048 + lane * 8;
    f32x4 a[4], b[4];
#pragma unroll
    for (int j = 0; j < 4; ++j) { a[j] = *(const f32x4*)(src + idx + 512 * j); b[j] = *(const f32x4*)(src + idx + 512 * j + 4); }
#pragma unroll
    for (int j = 0; j < 4; ++j) { v4u o; o.x = pk2(a[j][0], a[j][1]); o.y = pk2(a[j][2], a[j][3]); o.z = pk2(b[j][0], b[j][1]); o.w = pk2(b[j][2], b[j][3]); *(v4u*)(dst + idx + 512 * j) = o; }
}
__device__ __forceinline__ void final_row(const float* __restrict__ hrow, float rstd, const float* __restrict__ gf, float* __restrict__ yrow, int lane) {
#pragma unroll
    for (int j = 0; j < 4; ++j) { const f32x4 v = ((const f32x4*)hrow + lane)[64 * j], gg = ((const f32x4*)gf + lane)[64 * j]; ((f32x4*)yrow + lane)[64 * j] = v * rstd * gg; }
}

__device__ __forceinline__ void final_row_bf(const bf16* __restrict__ hrow, float rstd, const float* __restrict__ gf, float* __restrict__ yrow, int lane) {
#pragma unroll
    for (int j = 0; j < 2; ++j) { const v4u x = ((const v4u*)hrow + lane)[64 * j]; const f32x4 g0 = ((const f32x4*)gf)[(64 * j + lane) * 2], g1 = ((const f32x4*)gf)[(64 * j + lane) * 2 + 1];
        f32x4 a = {bflo(x.x), bfhi(x.x), bflo(x.y), bfhi(x.y)}, b = {bflo(x.z), bfhi(x.z), bflo(x.w), bfhi(x.w)};
        ((f32x4*)yrow)[(64 * j + lane) * 2] = a * rstd * g0; ((f32x4*)yrow)[(64 * j + lane) * 2 + 1] = b * rstd * g1; }
}

__device__ __forceinline__ int crow(int i, int hi) { return (i & 3) + 8 * (i >> 2) + 4 * hi; }
__device__ __forceinline__ s16x4 vtr(LAS unsigned char* p) { typedef short v4i16_t __attribute__((ext_vector_type(4))); return __builtin_bit_cast(s16x4, __builtin_amdgcn_ds_read_tr16_b64_v4i16((LAS v4i16_t*)p)); }
__device__ __forceinline__ unsigned cvtpk(float lo, float hi) { typedef float f2 __attribute__((ext_vector_type(2))); typedef __bf16 b2 __attribute__((ext_vector_type(2))); f2 v = {lo, hi}; b2 b = __builtin_convertvector(v, b2); return __builtin_bit_cast(unsigned, b); }
__device__ __forceinline__ void attn_tile(const bf16* __restrict__ X  , int h, int dsh, int r, int c0, LAS unsigned char* vst  ,
                                          bf16* __restrict__ OP  , float* __restrict__ LS  , int lane) {
    const int r32 = lane & 31, hi = lane >> 5;
    const int nskip = (c0 < 128) ? ((128 - c0) >> 5) : 0;
    const float NEG = -1e30f;
    bf16x8 qf[4];
    { const bf16* qp = X + (size_t)(((c0 + r32) << dsh) + r) * 2048 + h * 64 + 8 * hi;
#pragma unroll
      for (int ds = 0; ds < 4; ++ds) qf[ds] = *(const bf16x8*)(qp + 16 * ds); }
    f32x16 s[5];
#pragma unroll
    for (int blk = 0; blk < 5; ++blk) {
        if (blk >= nskip) {
            const int kc = c0 - 128 + 32 * blk + r32;
            const bf16* kp = X + (size_t)((kc << dsh) + r) * 2048 + 512 + h * 64 + 8 * hi;
            f32x16 a;
#pragma unroll
            for (int i = 0; i < 16; ++i) a[i] = 0.f;
#pragma unroll
            for (int ds = 0; ds < 4; ++ds) a = __builtin_amdgcn_mfma_f32_32x32x16_bf16(*(const bf16x8*)(kp + 16 * ds), qf[ds], a, 0, 0, 0);
            s[blk] = a;
        } else {
#pragma unroll
            for (int i = 0; i < 16; ++i) s[blk][i] = NEG;
        }
    }
#pragma unroll
    for (int i = 0; i < 16; ++i) { const int kr = crow(i, hi); if (kr < r32) s[0][i] = NEG; if (kr > r32) s[4][i] = NEG; }
    float m = s[4][0];
#pragma unroll
    for (int blk = 0; blk < 5; ++blk)
#pragma unroll
        for (int i = 0; i < 16; ++i) m = fmaxf(m, s[blk][i]);
    m = fmaxf(m, __shfl_xor(m, 32));
    float l = 0.f;
#pragma unroll
    for (int blk = 0; blk < 5; ++blk)
#pragma unroll
        for (int i = 0; i < 16; ++i) { const float p = __builtin_amdgcn_exp2f(s[blk][i] - m); s[blk][i] = p; l += p; }
    l += __shfl_xor(l, 32);
    f32x16 o[2];
#pragma unroll
    for (int i = 0; i < 16; ++i) { o[0][i] = 0.f; o[1][i] = 0.f; }
    const int vrow8 = (lane >> 2) & 7, vc = (lane & 3) + 4 * (lane >> 5);
    const int vb = (4 * hi + ((lane & 15) >> 2)) * 64 + ((lane >> 4) & 1) * 32 + (lane & 3) * 8;
#pragma unroll
    for (int blk = 0; blk < 5; ++blk) {
        if (blk >= nskip) {
            LAS unsigned char* buf = vst + (blk & 1) * 4096;
            const int kb = c0 - 128 + 32 * blk;
            v4u vv[4];
#pragma unroll
            for (int i = 0; i < 4; ++i) { const int kc = kb + 8 * i + vrow8; vv[i] = *(const v4u*)(X + (size_t)((kc << dsh) + r) * 2048 + 1024 + h * 64 + 8 * vc); }
#pragma unroll
            for (int i = 0; i < 4; ++i) *(LAS v4u*)(buf + i * 1024 + lane * 16) = vv[i];
            LDS_WAIT(); asm volatile("" ::: "memory");
#pragma unroll
            for (int s2 = 0; s2 < 2; ++s2) {
                v4u pw; pw.x = cvtpk(s[blk][8 * s2 + 0], s[blk][8 * s2 + 1]); pw.y = cvtpk(s[blk][8 * s2 + 2], s[blk][8 * s2 + 3]); pw.z = cvtpk(s[blk][8 * s2 + 4], s[blk][8 * s2 + 5]); pw.w = cvtpk(s[blk][8 * s2 + 6], s[blk][8 * s2 + 7]);
                const bf16x8 pf = __builtin_bit_cast(bf16x8, pw);
#pragma unroll
                for (int d0 = 0; d0 < 2; ++d0) {
                    const s16x4 a = vtr(buf + vb + (2 * s2) * 1024 + d0 * 512), b = vtr(buf + vb + (2 * s2 + 1) * 1024 + d0 * 512);
                    const bf16x8 vf = (bf16x8){a[0], a[1], a[2], a[3], b[0], b[1], b[2], b[3]};
                    o[d0] = __builtin_amdgcn_mfma_f32_32x32x16_bf16(vf, pf, o[d0], 0, 0, 0);
                }
            }
            LDS_WAIT(); asm volatile("" ::: "memory");
        }
    }
    const float inv = 1.0f / l;
    const int tq = ((c0 + r32) << dsh) + r;
    bf16* op = OP + (size_t)tq * 512 + h * 64 + 4 * hi;
#pragma unroll
    for (int d0 = 0; d0 < 2; ++d0)
#pragma unroll
        for (int gq = 0; gq < 4; ++gq) { v2u w; w.x = cvtpk(o[d0][4 * gq] * inv, o[d0][4 * gq + 1] * inv); w.y = cvtpk(o[d0][4 * gq + 2] * inv, o[d0][4 * gq + 3] * inv); *(v2u*)(op + 32 * d0 + 8 * gq) = w; }
    if (hi == 0) LS[(size_t)tq * 8 + h] = m + __builtin_amdgcn_logf(l);
}
__device__ __forceinline__ void merge_z_unit(const bf16* __restrict__ QKVU, const bf16* __restrict__ OPART, const float* __restrict__ LSE, bf16* __restrict__ AO, int b, int h, int T0, int tid) {
    const int ch = tid & 7, tg = tid >> 3;
    const int w = 2 << (h >> 1);
    const size_t rowb = (size_t)b * SEQ;
    const bf16* ub = QKVU + rowb * 2048 + 1536 + h * 64 + 8 * ch;
    float sacc[8];
#pragma unroll
    for (int e = 0; e < 8; ++e) sacc[e] = 0.f;
    const int tfirst = T0 + 8 * tg;
    for (int j = 1; j < w; ++j) { const int tt = tfirst - j; if (tt >= 0) { const v4u x = *(const v4u*)(ub + (size_t)tt * 2048);
        sacc[0] += bflo(x.x); sacc[1] += bfhi(x.x); sacc[2] += bflo(x.y); sacc[3] += bfhi(x.y); sacc[4] += bflo(x.z); sacc[5] += bfhi(x.z); sacc[6] += bflo(x.w); sacc[7] += bfhi(x.w); } }
#pragma unroll 1
    for (int i = 0; i < 8; ++i) {
        const int t = tfirst + i; const size_t row = rowb + t;
        const float l0 = LSE[((size_t)0 * M + row) * 8 + h], l1 = LSE[((size_t)1 * M + row) * 8 + h], l2 = LSE[((size_t)2 * M + row) * 8 + h];
        const float mx = fmaxf(l0, fmaxf(l1, l2));
        float w0 = __builtin_amdgcn_exp2f(l0 - mx), w1 = __builtin_amdgcn_exp2f(l1 - mx), w2 = __builtin_amdgcn_exp2f(l2 - mx);
        const float inv = 1.0f / (w0 + w1 + w2); w0 *= inv; w1 *= inv; w2 *= inv;
        const v4u a0 = *(const v4u*)(OPART + ((size_t)0 * M + row) * 512 + h * 64 + 8 * ch), a1 = *(const v4u*)(OPART + ((size_t)1 * M + row) * 512 + h * 64 + 8 * ch), a2 = *(const v4u*)(OPART + ((size_t)2 * M + row) * 512 + h * 64 + 8 * ch);
        v4u oa;
        oa.x = pk2(w0 * bflo(a0.x) + w1 * bflo(a1.x) + w2 * bflo(a2.x), w0 * bfhi(a0.x) + w1 * bfhi(a1.x) + w2 * bfhi(a2.x));
        oa.y = pk2(w0 * bflo(a0.y) + w1 * bflo(a1.y) + w2 * bflo(a2.y), w0 * bfhi(a0.y) + w1 * bfhi(a1.y) + w2 * bfhi(a2.y));
        oa.z = pk2(w0 * bflo(a0.z) + w1 * bflo(a1.z) + w2 * bflo(a2.z), w0 * bfhi(a0.z) + w1 * bfhi(a1.z) + w2 * bfhi(a2.z));
        oa.w = pk2(w0 * bflo(a0.w) + w1 * bflo(a1.w) + w2 * bflo(a2.w), w0 * bfhi(a0.w) + w1 * bfhi(a1.w) + w2 * bfhi(a2.w));
        *(v4u*)(AO + row * 1024 + h * 64 + 8 * ch) = oa;
        const v4u x = *(const v4u*)(ub + (size_t)t * 2048);
        float u8[8] = {bflo(x.x), bfhi(x.x), bflo(x.y), bfhi(x.y), bflo(x.z), bfhi(x.z), bflo(x.w), bfhi(x.w)};
#pragma unroll
        for (int e = 0; e < 8; ++e) sacc[e] += u8[e];
        const float rc = 1.0f / (float)((t + 1 < w) ? (t + 1) : w);
        v4u oz; oz.x = pk2(sacc[0] * rc - u8[0], sacc[1] * rc - u8[1]); oz.y = pk2(sacc[2] * rc - u8[2], sacc[3] * rc - u8[3]); oz.z = pk2(sacc[4] * rc - u8[4], sacc[5] * rc - u8[5]); oz.w = pk2(sacc[6] * rc - u8[6], sacc[7] * rc - u8[7]);
        *(v4u*)(AO + row * 1024 + 512 + h * 64 + 8 * ch) = oz;
        const int td = t + 1 - w;
        if (td >= 0) { const v4u y = *(const v4u*)(ub + (size_t)td * 2048);
            sacc[0] -= bflo(y.x); sacc[1] -= bfhi(y.x); sacc[2] -= bflo(y.y); sacc[3] -= bfhi(y.y); sacc[4] -= bflo(y.z); sacc[5] -= bfhi(y.z); sacc[6] -= bflo(y.w); sacc[7] -= bfhi(y.w); }
    }
}

__device__ __forceinline__ void sample_attn_unit(const float* __restrict__ ckv  , const float* __restrict__ spool  ,
                                                 const float* __restrict__ QS, const float* __restrict__ kvnew  , float* __restrict__ psout  ,
                                                 bf16* __restrict__ AOS, int bs, int h, LAS float* red, int wave, int lane, int tid) {
    const int ks = lane >> 4, d4 = lane & 15;
    const f32x4 q4 = *(const f32x4*)(QS + bs * 512 + h * 64 + 4 * d4);
    const float* cb = ckv + (size_t)bs * 2048 * 1024 + h * 64 + 4 * d4;
    const float* nk = kvnew + bs * 1024 + h * 64 + 4 * d4;
    float sc[13]; f32x4 vv[13];
#pragma unroll
    for (int i = 0; i < 13; ++i) {
        const int idx = wave * 52 + i * 4 + ks; const bool valid = idx < 387;
        const int g = (idx >= 258) ? 2 : ((idx >= 129) ? 1 : 0), j = idx - g * 129;
        const float* kp = (valid && j > 0) ? (cb + (size_t)(2048 - (j << (2 * g))) * 1024) : nk;
        const f32x4 k4 = *(const f32x4*)kp; vv[i] = *(const f32x4*)(kp + 512);
        float d = (q4[0] * k4[0] + q4[1] * k4[1]) + (q4[2] * k4[2] + q4[3] * k4[3]);
        d += __shfl_xor(d, 1); d += __shfl_xor(d, 2); d += __shfl_xor(d, 4); d += __shfl_xor(d, 8);
        sc[i] = valid ? d : -1e30f;
    }
    float m = sc[0];
#pragma unroll
    for (int i = 1; i < 13; ++i) m = fmaxf(m, sc[i]);
    m = fmaxf(m, __shfl_xor(m, 16)); m = fmaxf(m, __shfl_xor(m, 32));
    float l = 0.f; f32x4 o = {0.f, 0.f, 0.f, 0.f};
#pragma unroll
    for (int i = 0; i < 13; ++i) { const float p = __builtin_amdgcn_exp2f(sc[i] - m); l += p; o += vv[i] * p; }
    l += __shfl_xor(l, 16); l += __shfl_xor(l, 32);
#pragma unroll
    for (int e = 0; e < 4; ++e) { o[e] += __shfl_xor(o[e], 16); o[e] += __shfl_xor(o[e], 32); }
    if (ks == 0) *(LAS f32x4*)(red + wave * 68 + 4 * d4) = o;
    if (lane == 0) { red[wave * 68 + 64] = m; red[wave * 68 + 65] = l; }
    __syncthreads();
    if (tid < 64) {
        float mm = red[64];
#pragma unroll
        for (int w = 1; w < 8; ++w) mm = fmaxf(mm, red[w * 68 + 64]);
        float L = 0.f, O = 0.f;
#pragma unroll
        for (int w = 0; w < 8; ++w) { const float f = __builtin_amdgcn_exp2f(red[w * 68 + 64] - mm); L += red[w * 68 + 65] * f; O += red[w * 68 + tid] * f; }
        AOS[bs * 1024 + h * 64 + tid] = (bf16)f2bf(O / L);
    } else if (tid < 128) {
        const int col = h * 64 + (tid - 64); const int w = 2 << (h >> 1);
        const float un = psout[(size_t)(bs * 15 + 14) * 512 + col];
        float s = un;
        for (int j = 1; j < w; ++j) s += spool[(size_t)(bs * 15 + (15 - j)) * 512 + col];
        AOS[bs * 1024 + 512 + col] = (bf16)f2bf(s / (float)w - un);
    } else if (tid < 192) {
        const int col = h * 64 + (tid - 128);
#pragma unroll
        for (int i = 0; i < 14; ++i) psout[(size_t)(bs * 15 + i) * 512 + col] = spool[(size_t)(bs * 15 + i + 1) * 512 + col];
    }
    __syncthreads();
}
template <int K> __device__ __forceinline__ f32x4 sg_tile(const bf16* __restrict__ A, const bf16* __restrict__ Bt, int n0, LAS float* red, int wave, int lane, int tid) {
    constexpr int KW = K / 8;
    f32x4 acc[2][4];
#pragma unroll
    for (int a = 0; a < 2; ++a)
#pragma unroll
        for (int c = 0; c < 4; ++c) acc[a][c] = (f32x4){0.f, 0.f, 0.f, 0.f};
    const int r16 = lane & 15, kq = lane >> 4;
    const bf16* ap = A + (size_t)r16 * K + wave * KW + 8 * kq;
    const bf16* bp = Bt + (size_t)(n0 + r16) * K + wave * KW + 8 * kq;
#pragma unroll 2
    for (int k = 0; k < KW; k += 32) {
        const bf16x8 a0 = *(const bf16x8*)(ap + k), a1 = *(const bf16x8*)(ap + (size_t)16 * K + k);
#pragma unroll
        for (int c = 0; c < 4; ++c) { const bf16x8 bb = *(const bf16x8*)(bp + (size_t)c * 16 * K + k);
            acc[0][c] = __builtin_amdgcn_mfma_f32_16x16x32_bf16(a0, bb, acc[0][c], 0, 0, 0); acc[1][c] = __builtin_amdgcn_mfma_f32_16x16x32_bf16(a1, bb, acc[1][c], 0, 0, 0); }
    }
#pragma unroll
    for (int a = 0; a < 2; ++a)
#pragma unroll
        for (int c = 0; c < 4; ++c)
#pragma unroll
            for (int i = 0; i < 4; ++i) red[(wave * 32 + 16 * a + 4 * kq + i) * 64 + 16 * c + r16] = acc[a][c][i];
    __syncthreads();
    const int row = tid >> 4, c4 = (tid & 15) * 4;
    f32x4 sum = (f32x4){0.f, 0.f, 0.f, 0.f};
#pragma unroll
    for (int w = 0; w < 8; ++w) sum += *(const LAS f32x4*)(red + (w * 32 + row) * 64 + c4);
    return sum;
}
__device__ __forceinline__ float srstd(const float* __restrict__ sss, int row) {
    const f32x4* p = (const f32x4*)(sss + row * 16); const f32x4 a = p[0] + p[1] + p[2] + p[3];
    return __builtin_amdgcn_rsqf(((a[0] + a[1]) + (a[2] + a[3])) * (1.0f / 1024.0f) + 1e-6f);
}
__device__ __forceinline__ void sss_put(float* __restrict__ sss, int row, int task, const f32x4 o, int tid) {
    float q = (o[0] * o[0] + o[1] * o[1]) + (o[2] * o[2] + o[3] * o[3]);
    q += __shfl_xor(q, 1); q += __shfl_xor(q, 2); q += __shfl_xor(q, 4); q += __shfl_xor(q, 8);
    if ((tid & 15) == 0) sss[row * 16 + task] = q;
}

struct Args { const float* in[18]; float* out; unsigned char* ws; int ph_lo, ph_hi; };
#define IN(k) (lo <= (k) && (k) < hi)
#ifndef REP_P0
#define REP_P0 1
#endif
#ifndef REP_P1
#define REP_P1 1
#endif
#ifndef REP_P2
#define REP_P2 1
#endif
#ifndef REP_P2S
#define REP_P2S 1
#endif
#ifndef REP_P4
#define REP_P4 1
#endif
#ifndef REP_P3
#define REP_P3 1
#endif
#ifndef REP_P5
#define REP_P5 1
#endif
#ifndef REP_P6
#define REP_P6 1
#endif
#ifndef REP_PE
#define REP_PE 1
#endif
#ifndef REP_S1
#define REP_S1 1
#endif
#ifndef REP_S4
#define REP_S4 1
#endif
#define SEAM(k) do { if (IN((k) + 1)) { bar.bar = (unsigned*)(KWS() + WS_CTL) + CW_BAR; xcd_barrier(bar); } } while (0)
#define PH_TID() int lane = (int)__builtin_amdgcn_mbcnt_hi(~0u, __builtin_amdgcn_mbcnt_lo(~0u, 0u)); asm volatile("" : "+v"(lane)); const int tid = wave * 64 + lane;
template <int L> __device__ __forceinline__ void layer_phases(LAS unsigned char* lds, const int lo, const int hi, const int G, const int bx, const int wave, XcdBarrier& bar) {
    constexpr int l = L;
    LAS float* red0 = (LAS float*)(lds + RING_OFF); LAS float* red1 = (LAS float*)(lds + RING_OFF + 65536);
        const int pb = 1 + 6 * l;
        if (IN(pb + 0)) {
            PH_TID();
            for (int rep = 0; rep < REP_S1; ++rep)
            if (bx < DIN / 64) {
                unsigned char* ws = KWS(); float* outp = KOUT();
                const bf16* hsbx = (const bf16*)(ws + WS_SMP + ((l & 1) ? SMP_HSB1 : SMP_HSB0));
                for (int t = bx; t < DIN / 64; t += G) {
                    const f32x4 v = sg_tile<D>(hsbx, (const bf16*)(ws + WS_W + l * W_LAYER + W_IN), t * 64, red0, wave, lane, tid) * srstd((const float*)(ws + WS_SMP + SMP_SSS), tid >> 4);
                    const int row = tid >> 4, col = t * 64 + (tid & 15) * 4;
                    if (col < 512) *(f32x4*)((float*)(ws + WS_SMP + SMP_QS) + row * 512 + col) = v * QSCALE;
                    else if (col < 1536) *(f32x4*)(outp + O_KVS + (size_t)l * SB * 1024 + row * 1024 + (col - 512)) = v;
                    else *(f32x4*)(outp + O_PS + (size_t)l * SB * PBUF * DP + (size_t)(row * 15 + 14) * 512 + (col - 1536)) = v;
                    __syncthreads();
                }
            }
            unsigned char* ws = KWS();
            pg8::Gemm g{(const bf16*)(ws + ((l & 1) ? WS_HB1 : WS_HB0)), (const bf16*)(ws + WS_W + l * W_LAYER + W_IN), M, DIN, D}; pg8::StaticOrder S; S.init(M, DIN, G, bx);
            pg8::EpiProj E{l};
            for (int rep = 0; rep < REP_P1; ++rep)
            pg8::gemm_phase<pg8::EpiProj, pg8::StaticOrder, true, true>(lds + RING_OFF, g, S, E, wave);
            SEAM(pb + 0);
        }
        if (IN(pb + 1)) {
            PH_TID();
            { unsigned char* ws = KWS(); float* outp = KOUT();
              const float* cache_kv = KIN(2) + (size_t)l * SB * 2048 * 1024; const float* state_pool = KIN(3) + (size_t)l * SB * PBUF * DP;
              for (int rep = 0; rep < REP_P2S; ++rep)
              for (int su = bx; su < SB * 8; su += G)
                sample_attn_unit(cache_kv, state_pool, (const float*)(ws + WS_SMP + SMP_QS), outp + O_KVS + (size_t)l * SB * 1024, outp + O_PS + (size_t)l * SB * PBUF * DP, (bf16*)(ws + WS_SMP + SMP_AOS), su >> 3, su & 7, red0, wave, lane, tid); }
            { unsigned char* ws = KWS();
              const bf16* QKVU = (const bf16*)(ws + WS_QKVU); bf16* OPART = (bf16*)(ws + WS_OPART); float* LSE = (float*)(ws + WS_LSE);
              for (int rep = 0; rep < REP_P2; ++rep)
              for (int uid = bx; uid < 256; uid += G) {
                const int h = uid & 7, bc = uid >> 3, b = bc >> 4, T0 = (bc & 15) * 512;
                const bf16* X = QKVU + (size_t)b * SEQ * 2048;
                LAS unsigned char* vst = lds + RING_OFF + 8192 + wave * 8192;
                for (int tile = wave; tile < 48; tile += 8) {
                    const int gp = tile >> 4, idx = tile & 15;
                    int dsh, r, c0;
                    if (gp == 0) { dsh = 0; r = 0; c0 = T0 + 32 * idx; }
                    else if (gp == 1) { dsh = 2; r = idx & 3; c0 = (T0 >> 2) + 32 * (idx >> 2); }
                    else { dsh = 4; r = idx; c0 = T0 >> 4; }
                    attn_tile(X, h, dsh, r, c0, vst, OPART + ((size_t)gp * M + (size_t)b * SEQ) * 512, LSE + ((size_t)gp * M + (size_t)b * SEQ) * 8, lane);
                }
                VM_WAIT(); __syncthreads();
                merge_z_unit(QKVU, OPART, LSE, (bf16*)(ws + WS_AO), b, h, T0, tid);
              } }
            SEAM(pb + 1);
        }
        if (IN(pb + 2)) {
            PH_TID();
            if (bx < D / 64) {
                unsigned char* ws = KWS();
                float* HS = (float*)(ws + WS_SMP + SMP_HS); bf16* hsbx = (bf16*)(ws + WS_SMP + ((l & 1) ? SMP_HSB1 : SMP_HSB0));
                for (int t = bx; t < D / 64; t += G) {
                    const f32x4 s = sg_tile<D>((const bf16*)(ws + WS_SMP + SMP_AOS), (const bf16*)(ws + WS_W + l * W_LAYER + W_OUT), t * 64, red0, wave, lane, tid);
                    const int row = tid >> 4, col = t * 64 + (tid & 15) * 4;
                    const f32x4 o = *(const f32x4*)(HS + row * D + col) + s;
                    *(f32x4*)(HS + row * D + col) = o; v2u w; w.x = pk2(o[0], o[1]); w.y = pk2(o[2], o[3]); *(v2u*)(hsbx + row * D + col) = w;
                    sss_put((float*)(ws + WS_SMP + SMP_SSS) + 512, row, t, o, tid);
                    __syncthreads();
                }
            }
            unsigned char* ws = KWS();
            pg8::Gemm g{(const bf16*)(ws + WS_AO), (const bf16*)(ws + WS_W + l * W_LAYER + W_OUT), M, D, D}; pg8::StaticOrder S; S.init(M, D, G, bx);
            for (int rep = 0; rep < REP_P3; ++rep) {
            pg8::EpiRes E{l, 0, rep < REP_P3 - 1};
            pg8::gemm_phase<pg8::EpiRes, pg8::StaticOrder, false, true>(lds + RING_OFF, g, S, E, wave); }
            SEAM(pb + 2);
        }
        if (IN(pb + 3)) {
            PH_TID();
            for (int rep = 0; rep < REP_S4; ++rep)
            if (bx < DFF / 64) {
                unsigned char* ws = KWS();
                bf16* ACTS = (bf16*)(ws + WS_SMP + SMP_ACTS);
                for (int t = bx; t < DFF / 64; t += G) {
                    const f32x4 s = sg_tile<D>((const bf16*)(ws + WS_SMP + ((l & 1) ? SMP_HSB1 : SMP_HSB0)), (const bf16*)(ws + WS_W + l * W_LAYER + W_UP), t * 64, red0, wave, lane, tid) * srstd((const float*)(ws + WS_SMP + SMP_SSS) + 512, tid >> 4);
                    const int row = tid >> 4, col = t * 64 + (tid & 15) * 4;
                    const float a0 = fmaxf(s[0], 0.f), a1 = fmaxf(s[1], 0.f), a2 = fmaxf(s[2], 0.f), a3 = fmaxf(s[3], 0.f);
                    v2u w; w.x = pk2(a0 * a0, a1 * a1); w.y = pk2(a2 * a2, a3 * a3); *(v2u*)(ACTS + row * DFF + col) = w;
                    __syncthreads();
                }
            }
            unsigned char* ws = KWS();
            pg8::Gemm g{(const bf16*)(ws + ((l & 1) ? WS_HB1 : WS_HB0)), (const bf16*)(ws + WS_W + l * W_LAYER + W_UP), M, DFF, D}; pg8::StaticOrder S; S.init(M, DFF, G, bx);
            pg8::EpiUp E{l};
            for (int rep = 0; rep < REP_P4; ++rep)
            pg8::gemm_phase<pg8::EpiUp, pg8::StaticOrder, true, true>(lds + RING_OFF, g, S, E, wave);
            SEAM(pb + 3);
        }
        if (IN(pb + 4)) {
            PH_TID();
            if (bx < D / 64) {
                unsigned char* ws = KWS();
                float* HS = (float*)(ws + WS_SMP + SMP_HS); bf16* hsbx = (bf16*)(ws + WS_SMP + ((l & 1) ? SMP_HSB1 : SMP_HSB0));
                for (int t = bx; t < D / 64; t += G) {
                    const f32x4 s = sg_tile<DFF>((const bf16*)(ws + WS_SMP + SMP_ACTS), (const bf16*)(ws + WS_W + l * W_LAYER + W_DN), t * 64, red0, wave, lane, tid);
                    const int row = tid >> 4, col = t * 64 + (tid & 15) * 4;
                    const f32x4 o = *(const f32x4*)(HS + row * D + col) + s;
                    *(f32x4*)(HS + row * D + col) = o; v2u w; w.x = pk2(o[0], o[1]); w.y = pk2(o[2], o[3]); *(v2u*)(hsbx + row * D + col) = w;
                    sss_put((float*)(ws + WS_SMP + SMP_SSS) + 1024, row, t, o, tid);
                    __syncthreads();
                }
            }
            unsigned char* ws = KWS();
            pg8::Gemm g{(const bf16*)(ws + WS_ACT), (const bf16*)(ws + WS_W + l * W_LAYER + W_DN), M, D, DFF}; pg8::StaticOrder S; S.init(M, D, G, bx);
            for (int rep = 0; rep < REP_P5; ++rep) {
            pg8::EpiRes E{l, 1, rep < REP_P5 - 1};
            pg8::gemm_phase<pg8::EpiRes, pg8::StaticOrder, false, true>(lds + RING_OFF, g, S, E, wave); }
            SEAM(pb + 4);
        }
        if (IN(pb + 5)) {
            PH_TID();
            if (bx < D / 64) {
                unsigned char* ws = KWS();
                float* HS = (float*)(ws + WS_SMP + SMP_HS); bf16* hsby = (bf16*)(ws + WS_SMP + ((l & 1) ? SMP_HSB0 : SMP_HSB1));
                for (int t = bx; t < D / 64; t += G) {
                    const f32x4 gt = sg_tile<D>((const bf16*)(ws + WS_SMP + ((l & 1) ? SMP_HSB1 : SMP_HSB0)), (const bf16*)(ws + WS_W + l * W_LAYER + W_GT), t * 64, red0, wave, lane, tid) * (srstd((const float*)(ws + WS_SMP + SMP_SSS) + 1024, tid >> 4) * -1.4426950408889634f);
                    const f32x4 pe = sg_tile<DPLE>((const bf16*)(ws + WS_SMP + SMP_PSB) + (size_t)l * SB * DPLE, (const bf16*)(ws + WS_W + l * W_LAYER + W_PL), t * 64, red1, wave, lane, tid);
                    const int row = tid >> 4, col = t * 64 + (tid & 15) * 4;
                    f32x4 o = *(const f32x4*)(HS + row * D + col);
#pragma unroll
                    for (int e = 0; e < 4; ++e) o[e] += pe[e] * __builtin_amdgcn_rcpf(1.0f + __builtin_amdgcn_exp2f(gt[e]));
                    *(f32x4*)(HS + row * D + col) = o; v2u w; w.x = pk2(o[0], o[1]); w.y = pk2(o[2], o[3]); *(v2u*)(hsby + row * D + col) = w;
                    sss_put((float*)(ws + WS_SMP + SMP_SSS), row, t, o, tid);
                    __syncthreads();
                }
            }
            { unsigned char* ws = KWS();
              pg8::Gemm g{(const bf16*)(ws + WS_PB) + (size_t)l * M * DPLE, (const bf16*)(ws + WS_W + l * W_LAYER + W_PL), M, D, DPLE}; pg8::StaticOrder S; S.init(M, D, G, bx);
              pg8::EpiPlain E{D};
              for (int rep = 0; rep < REP_PE; ++rep)
              pg8::gemm_phase<pg8::EpiPlain, pg8::StaticOrder, false, true>(lds + RING_OFF, g, S, E, wave); }
            { unsigned char* ws = KWS();
              pg8::Gemm g{(const bf16*)(ws + ((l & 1) ? WS_HB1 : WS_HB0)), (const bf16*)(ws + WS_W + l * W_LAYER + W_GT), M, D, D}; pg8::StaticOrder S; S.init(M, D, G, bx);
              for (int rep = 0; rep < REP_P6; ++rep) {
              pg8::EpiGate E{l, rep < REP_P6 - 1};
              pg8::gemm_phase<pg8::EpiGate, pg8::StaticOrder, false, true>(lds + RING_OFF, g, S, E, wave); } }
            SEAM(pb + 5);
        }
}
__global__ void __launch_bounds__(NWAVES * 64, 2) fwd(Args args) {
    extern __shared__ __attribute__((aligned(16))) unsigned char lds_raw[];
    LAS unsigned char* lds = (LAS unsigned char*)lds_raw;
    volatile LAS unsigned* MISC = (volatile LAS unsigned*)(lds + MISC_OFF);
    const int tid0 = threadIdx.x, wave = __builtin_amdgcn_readfirstlane(tid0 >> 6);
    const int G = gridDim.x, bx = blockIdx.x;
    for (int u = tid0; u < (LDS_BYTES - LDSCTL_OFF) / 4; u += NWAVES * 64) ((LAS unsigned*)(lds + LDSCTL_OFF))[u] = 0u;
    __syncthreads();
    const int lo = args.ph_lo, hi = args.ph_hi;
    XcdBarrier bar; bar.bar = nullptr; bar.x = 0; bar.st = MISC + 8;
    if (hi - lo > 1) bar = xcd_barrier_post((unsigned*)(KWS() + WS_CTL) + CW_BAR, MISC + 8);
    LAS float* red0 = (LAS float*)(lds + RING_OFF); LAS float* red1 = (LAS float*)(lds + RING_OFF + 65536);

    if (IN(0)) {
            PH_TID();
        for (int rep = 0; rep < REP_P0; ++rep) {
        const int vcu = (G % 8 == 0) ? (bx % 8) * (G / 8) + bx / 8 : bx;
        const int gw = vcu * NWAVES + wave, NGW = G * NWAVES;
        unsigned char* ws = KWS();
        LAS float* scr = (LAS float*)(lds + RING_OFF + wave * 16384);
        constexpr int I_FOLD = 256, I_IN = 1024, I_OUT = 256, I_UP = 2048, I_DN = 2048, I_GT = 512, I_PL = 128, I_REST = I_IN + I_OUT + I_UP + I_DN + I_GT + I_PL;
        { const float* pool_w = KIN(8); const float* pool_scale = KIN(9); const float* w_out = KIN(10);
          for (int it = (gw & 1) ? NL * I_FOLD : (gw >> 1); it < NL * I_FOLD; it += NGW / 2) { const int l = it / I_FOLD, r = it % I_FOLD;
            fold_item(pool_w + (size_t)l * 4 * 128 * 128, pool_scale + l * 512, w_out + (size_t)l * 1024 * 1024, (bf16*)(ws + WS_W + l * W_LAYER + W_OUT), scr, r, lane); } }
        for (int it = gw; it < NL * I_REST; it += NGW) { const int l = it / I_REST; int r = it % I_REST;
            unsigned char* wl = ws + WS_W + l * W_LAYER;
            const float* W; int N; const float* g; bf16* WT; int ldk;
            if (r < I_IN) { W = KIN(7) + (size_t)l * 1024 * 2048; N = 2048; g = KIN(6) + l * 1024; WT = (bf16*)(wl + W_IN); ldk = 1024; }
            else if ((r -= I_IN) < I_OUT) { W = KIN(10) + (size_t)l * 1024 * 1024; N = 1024; g = nullptr; WT = (bf16*)(wl + W_OUT); ldk = 1024; }
            else if ((r -= I_OUT) < I_UP) { W = KIN(12) + (size_t)l * 1024 * 4096; N = 4096; g = KIN(11) + l * 1024; WT = (bf16*)(wl + W_UP); ldk = 1024; }
            else if ((r -= I_UP) < I_DN) { W = KIN(13) + (size_t)l * 4096 * 1024; N = 1024; g = nullptr; WT = (bf16*)(wl + W_DN); ldk = 4096; }
            else if ((r -= I_DN) < I_GT) { W = KIN(15) + (size_t)l * 1024 * 1024; N = 1024; g = KIN(14) + l * 1024; WT = (bf16*)(wl + W_GT); ldk = 1024; }
            else { r -= I_GT; W = KIN(16) + (size_t)l * 256 * 1024; N = 1024; g = nullptr; WT = (bf16*)(wl + W_PL); ldk = 256; }
            tr_item(W, N, g, WT, ldk, scr, r, lane); }
        { const float* x_prompt = KIN(0); bf16* HB0 = (bf16*)(ws + WS_HB0); float* SS_A = (float*)(ws + WS_SS);
          for (int m = gw; m < M; m += 2 * NGW) xrow2_item(x_prompt + (size_t)m * D, HB0 + (size_t)m * D, SS_A + (size_t)m * 4, (size_t)NGW, lane); }
        { const float* p_prompt = KIN(4); bf16* PB = (bf16*)(ws + WS_PB);
          for (int it = gw; it < NL * M * DPLE / 2048; it += NGW) cvt_item4(p_prompt, PB, it, lane); }
        { const float* x_sample = KIN(1); unsigned char* smp = ws + WS_SMP;
          for (int m = gw; m < SB; m += NGW) xrow_item(x_sample + (size_t)m * D, (bf16*)(smp + SMP_HSB0) + (size_t)m * D, (float*)(smp + SMP_SSS) + m * 16, 16, (float*)(smp + SMP_HS) + (size_t)m * D, lane);
          const float* p_sample = KIN(5);
          for (int it = gw; it < NL * SB * DPLE / 2048; it += NGW) cvt_item4(p_sample, (bf16*)(smp + SMP_PSB), it, lane); }
        }
        VM_WAIT(); __syncthreads();
        SEAM(0);
    }

    layer_phases<0>(lds, lo, hi, G, bx, wave, bar);
    layer_phases<1>(lds, lo, hi, G, bx, wave, bar);
    layer_phases<2>(lds, lo, hi, G, bx, wave, bar);
    layer_phases<3>(lds, lo, hi, G, bx, wave, bar);
    if (IN(N_PHASES - 1)) {
            PH_TID();
        const int gw = bx * NWAVES + wave, NGW = G * NWAVES;
        unsigned char* ws = KWS(); float* outp = KOUT(); const float* g_final = KIN(17);
        const bf16* HBF = (const bf16*)(ws + ((NL & 1) ? WS_HB1 : WS_HB0)); const float* SS_A = (const float*)(ws + WS_SS);
        for (int m = gw; m < M; m += NGW) final_row_bf(HBF + (size_t)m * D, pg8::row_rstd(SS_A, m), g_final, outp + O_YP + (size_t)m * D, lane);
        for (int m = gw; m < SB; m += NGW) final_row((const float*)(ws + WS_SMP + SMP_HS) + (size_t)m * D, srstd((const float*)(ws + WS_SMP + SMP_SSS), m), g_final, outp + O_YS + (size_t)m * D, lane);
    }
#undef IN
#undef SEAM
}

extern "C" void kernel_launch(void* const* d_in, const int* in_sizes, int n_in, void* d_out, int out_size, void* d_ws, size_t ws_size, hipStream_t stream) {
    static int grid = 0;
    if (grid == 0) {
        if (n_in != 18 || in_sizes[0] != M * D || (size_t)out_size != O_END || ws_size < WS_END) { fprintf(stderr, "kernel_launch: unexpected shapes (n_in %d, in0 %d, out %d, ws %zu); nothing launched\n", n_in, n_in > 0 ? in_sizes[0] : -1, out_size, ws_size); grid = -1; return; }
        int dev = 0, cus = 0, per_cu = 0;
        if (hipGetDevice(&dev) != hipSuccess || hipDeviceGetAttribute(&cus, hipDeviceAttributeMultiprocessorCount, dev) != hipSuccess) { fprintf(stderr, "kernel_launch: device query failed\n"); grid = -1; return; }
        if (hipFuncSetAttribute((const void*)fwd, hipFuncAttributeMaxDynamicSharedMemorySize, LDS_BYTES) != hipSuccess) { fprintf(stderr, "kernel_launch: hipFuncSetAttribute failed\n"); grid = -1; return; }
        if (hipOccupancyMaxActiveBlocksPerMultiprocessor(&per_cu, (const void*)fwd, NWAVES * 64, LDS_BYTES) != hipSuccess || per_cu < 1) fprintf(stderr, "kernel_launch: note: occupancy query reports %d workgroups per CU\n", per_cu);
        (void)hipGetLastError();
        grid = cus;
        if (grid != 256) fprintf(stderr, "kernel_launch: %d CUs: this kernel is built for a 256-CU device\n", grid);
    }
    if (grid < 0) return;
    if (hipMemsetAsync((char*)d_ws + WS_CTL, 0, CTL_ZERO_BYTES, stream) != hipSuccess) { fprintf(stderr, "kernel_launch: memset failed\n"); return; }
    Args a{};
    for (int i = 0; i < 18; ++i) a.in[i] = (const float*)d_in[i];
    a.out = (float*)d_out; a.ws = (unsigned char*)d_ws;
#if MK_SPLIT
    for (int p = 0; p < N_PHASES; ++p) { a.ph_lo = p; a.ph_hi = p + 1; hipLaunchKernelGGL(fwd, dim3(grid), dim3(NWAVES * 64), LDS_BYTES, stream, a); }
#else
    a.ph_lo = 0; a.ph_hi = N_PHASES;
    hipLaunchKernelGGL(fwd, dim3(grid), dim3(NWAVES * 64), LDS_BYTES, stream, a);
#endif
    const hipError_t le = hipPeekAtLastError();
    if (le != hipSuccess) fprintf(stderr, "kernel_launch: launch failed: %s\n", hipGetErrorName(le));
}
```

```cpp
#include <hip/hip_runtime.h>
#include <cstdio>
#include <cstdint>
#ifndef MK_SPLIT
#define MK_SPLIT 0
#endif
constexpr int NWAVES = 8;

constexpr int NL = 4, NB = 2, SEQ = 8192, M = NB * SEQ, D = 1024, DIN = 2048, DFF = 4096, DPLE = 256, SB = 32, WBUF = 2048, PBUF = 15, DP = 512;
constexpr float QSCALE = 0.125f * 1.4426950408889634f;
constexpr int N_PHASES = 2 + 6 * NL;
constexpr size_t O_YP = 0, O_YS = (size_t)M * D, O_KVP = O_YS + (size_t)SB * D, O_KVS = O_KVP + (size_t)NL * NB * WBUF * 1024, O_PP = O_KVS + (size_t)NL * SB * 1024,
                 O_PS = O_PP + (size_t)NL * NB * PBUF * DP, O_END = O_PS + (size_t)NL * SB * PBUF * DP;
static_assert(O_END == 34762752, "d_out size");

constexpr size_t MiB = 1u << 20, KiB = 1u << 10;
constexpr size_t WS_CTL = 0, CTL_ZERO_BYTES = 1 * MiB;
constexpr size_t WS_W = 2 * MiB, W_LAYER = 25 * MiB;
constexpr size_t W_IN = 0, W_OUT = 4 * MiB, W_UP = 6 * MiB, W_DN = 14 * MiB, W_GT = 22 * MiB, W_PL = 24 * MiB;
constexpr size_t WS_HB0 = 104 * MiB, WS_HB1 = 136 * MiB;
constexpr size_t WS_H = 168 * MiB;
constexpr size_t WS_QKVU = 232 * MiB;
constexpr int QP = 2048;
constexpr size_t WS_AO = 200 * MiB;
constexpr size_t WS_ACT = 328 * MiB;
constexpr size_t WS_PE = 456 * MiB;
constexpr size_t WS_PB = 488 * MiB;
constexpr size_t WS_OPART = 520 * MiB;
constexpr size_t WS_LSE = 568 * MiB;
constexpr size_t WS_SS = 570 * MiB;
constexpr size_t WS_SMP = 572 * MiB;
constexpr size_t WS_END = 576 * MiB;
constexpr size_t SMP_HS = 0, SMP_HSB0 = 128 * KiB, SMP_HSB1 = 192 * KiB, SMP_QS = 256 * KiB, SMP_AOS = 320 * KiB, SMP_ACTS = 384 * KiB, SMP_PSB = 640 * KiB, SMP_SSS = 704 * KiB;
constexpr int CW_TMO = 0, CW_BAR = 4096;

constexpr int RING_OFF = 0, RING_BYTES = 131072;
constexpr int LDSCTL_OFF = RING_BYTES, MISC_OFF = LDSCTL_OFF + 320;
constexpr int LDS_BYTES = 147456;
static_assert(MISC_OFF + 128 <= LDS_BYTES, "LDS map");

#define GAS __attribute__((address_space(1)))
#define LAS __attribute__((address_space(3)))
typedef unsigned short bf16;
typedef unsigned v4u __attribute__((ext_vector_type(4)));
typedef unsigned v2u __attribute__((ext_vector_type(2)));
typedef float f32x4 __attribute__((ext_vector_type(4)));
typedef float f32x16 __attribute__((ext_vector_type(16)));
typedef short bf16x8 __attribute__((ext_vector_type(8)));
typedef short s16x4 __attribute__((ext_vector_type(4)));
typedef GAS unsigned gu32;
#define LDS_WAIT() asm volatile("s_waitcnt lgkmcnt(0)" ::: "memory")
#define VM_WAIT() asm volatile("s_waitcnt vmcnt(0)" ::: "memory")
__device__ __forceinline__ unsigned f2bf(float f) { unsigned u = __builtin_bit_cast(unsigned, f); return (u + 0x7fffu + ((u >> 16) & 1u)) >> 16; }
__device__ __forceinline__ unsigned pk2(float lo, float hi) { return f2bf(lo) | (f2bf(hi) << 16); }
__device__ __forceinline__ float bflo(unsigned w) { return __uint_as_float(w << 16); }
__device__ __forceinline__ float bfhi(unsigned w) { return __uint_as_float(w & 0xffff0000u); }
__device__ __forceinline__ float wave_sum(float v) {
#pragma unroll
    for (int o = 1; o < 64; o <<= 1) v += __shfl_xor(v, o);
    return v;
}

template <int OFF> __device__ __forceinline__ unsigned long long karg64() {
    unsigned long long v;
    asm volatile("s_load_dwordx2 %0, %1, %2\n\ts_waitcnt lgkmcnt(0)" : "=s"(v) : "s"(__builtin_amdgcn_kernarg_segment_ptr()), "i"(OFF));
    return v;
}
#define KIN(i) ((const float*)(const GAS float*)karg64<8 * (i)>())
#define KOUT() ((float*)(GAS float*)karg64<144>())
#define KWS() ((unsigned char*)(GAS unsigned char*)karg64<152>())

namespace pg8 {
#define PG8_LAS __attribute__((address_space(3)))
typedef unsigned short bf16_t;
typedef short bf16x8 __attribute__((ext_vector_type(8)));
typedef float f32x4 __attribute__((ext_vector_type(4)));
typedef unsigned u32x4 __attribute__((ext_vector_type(4)));
constexpr int BM = 256, BK = 64, HALF = 128, HTB = HALF * BK * 2  , STAGE_BYTES = 8 * HTB, NXCD = 8, WGM = 8;

__host__ __device__ __forceinline__ int lds_byte(int r, int c) { const int st = (r >> 4) * 2 + (c >> 5), rr = r & 15, cc = c & 31, ob = rr * 64 + cc * 2; return st * 1024 + (ob ^ (((ob >> 9) & 1) << 5)); }
__host__ __device__ __forceinline__ void stage_rc(int b, int& R, int& C) { const int st = b / 1024, sb = b % 1024, swz = sb ^ (((sb >> 9) & 1) << 5); R = (st >> 1) * 16 + swz / 64; C = (st & 1) * 32 + (swz % 64) / 2; }
__host__ __device__ __forceinline__ int perm32(int rho) { const int n = rho >> 4, i = rho & 15; return 8 * (i >> 2) + 4 * n + (i & 3); }

struct Unit { int pm, pn; };
struct Gemm { const bf16_t* A; const bf16_t* Bt; int M, N, K; };

struct StaticOrder {
    int nM, nN, nwg, G, c;
    __host__ __device__ void init(int M, int N, int G_, int c_) { nM = M / BM; nN = N / BM; nwg = nM * nN; G = G_; c = c_; }
    __host__ __device__ bool next(int i, Unit& u) const {
        const long L = (long)i * G + c; if (L >= nwg) return false;
        int wgid = (int)L; { const int q = nwg / NXCD, r = nwg % NXCD, xcd = wgid % NXCD, off = wgid / NXCD; wgid = (xcd < r ? xcd * (q + 1) : r * (q + 1) + (xcd - r) * q) + off; }
        const int nig = WGM * nN, gid = wgid / nig, fm = gid * WGM, gsz = (nM - fm) < WGM ? (nM - fm) : WGM;
        u.pm = fm + ((wgid % nig) % gsz); u.pn = (wgid % nig) / gsz; return true;
    }
    __device__ __forceinline__ void a_ready(const Unit&) const {}
    __device__ __forceinline__ void done(const Unit&) const {}
};

__device__ __forceinline__ unsigned cvt_pk_bf16(float lo, float hi) { unsigned r; asm volatile("v_cvt_pk_bf16_f32 %0, %1, %2" : "=v"(r) : "v"(lo), "v"(hi)); return r; }
typedef float f32x2 __attribute__((ext_vector_type(2)));
typedef unsigned u32x2 __attribute__((ext_vector_type(2)));
__device__ __forceinline__ u32x4 pack8(const f32x4 a, const f32x4 b) { u32x4 w; w.x = cvt_pk_bf16(a[0], a[1]); w.y = cvt_pk_bf16(a[2], a[3]); w.z = cvt_pk_bf16(b[0], b[1]); w.w = cvt_pk_bf16(b[2], b[3]); return w; }
__device__ __forceinline__ float dot4(const f32x4 a) { return (a[0] * a[0] + a[1] * a[1]) + (a[2] * a[2] + a[3] * a[3]); }
__device__ __forceinline__ float row_rstd(const float* ss, int row) { const f32x4 s = *(const f32x4*)(ss + (size_t)row * 4); return __builtin_amdgcn_rsqf(((s[0] + s[1]) + (s[2] + s[3])) * (1.0f / 1024.0f) + 1e-6f); }
__device__ __forceinline__ void unpack8(const u32x4 w, f32x4& a, f32x4& b) {
    a[0] = __uint_as_float(w.x << 16); a[1] = __uint_as_float(w.x & 0xffff0000u); a[2] = __uint_as_float(w.y << 16); a[3] = __uint_as_float(w.y & 0xffff0000u);
    b[0] = __uint_as_float(w.z << 16); b[1] = __uint_as_float(w.z & 0xffff0000u); b[2] = __uint_as_float(w.w << 16); b[3] = __uint_as_float(w.w & 0xffff0000u); }

struct EpiPlain {
    static constexpr bool PERM = true, AFTER_DRAIN = false;
    int ldc;
    __device__ __forceinline__ void operator()(const f32x4 (&acc)[2][2][4][2], const Unit& u, int wr, int wc, int fr, int fq) const {
        asm volatile("" : "+v"(fr), "+v"(fq));
        bf16_t* O = (bf16_t*)(KWS() + WS_PE);
        const int row0 = u.pm * BM + wr * 64 + fr, col0 = u.pn * BM + wc * 32 + 8 * fq;
#pragma unroll
        for (int ai = 0; ai < 2; ++ai)
#pragma unroll
            for (int m = 0; m < 4; ++m) { bf16_t* rowp = O + (size_t)(row0 + ai * HALF + m * 16) * ldc + col0;
#pragma unroll
                for (int bj = 0; bj < 2; ++bj) *(u32x4*)(rowp + bj * HALF) = pack8(acc[ai][bj][m][0], acc[ai][bj][m][1]); }
    }
};
struct EpiProj {
    static constexpr bool PERM = true, AFTER_DRAIN = false;
    int l;
    __device__ __forceinline__ void operator()(const f32x4 (&acc)[2][2][4][2], const Unit& u, int wr, int wc, int fr, int fq) const {
        asm volatile("" : "+v"(fr), "+v"(fq));
        unsigned char* ws = KWS(); float* outp = KOUT();
        bf16_t* O = (bf16_t*)(ws + WS_QKVU); const float* ss = (const float*)(ws + WS_SS);
        float* kv_out = outp + O_KVP + (size_t)l * NB * WBUF * 1024; float* pool_out = outp + O_PP + (size_t)l * NB * PBUF * DP;
        const int row0 = u.pm * BM + wr * 64 + fr, col0 = u.pn * BM + wc * 32 + 8 * fq;
        const float sc = (u.pn < 2) ? QSCALE : 1.0f;
        const int b = u.pm >> 5, t0 = (u.pm & 31) * BM + wr * 64 + fr;
        const bool kvt = (u.pn >= 2) && (u.pn < 6) && ((u.pm & 31) >= 24);
        const bool plt = (u.pn >= 6) && ((u.pm & 31) == 31);
#pragma unroll
        for (int ai = 0; ai < 2; ++ai)
#pragma unroll
            for (int m = 0; m < 4; ++m) { const int row = row0 + ai * HALF + m * 16, t = t0 + ai * HALF + m * 16;
                const float rs = row_rstd(ss, row);
#pragma unroll
                for (int bj = 0; bj < 2; ++bj) { const int col = col0 + bj * HALF;
                    const f32x4 v0 = acc[ai][bj][m][0] * rs, v1 = acc[ai][bj][m][1] * rs;
                    *(u32x4*)(O + (size_t)row * QP + col) = pack8(v0 * sc, v1 * sc);
                    if (kvt) { float* p = kv_out + ((size_t)(b * 2048 + (t - 6144)) * 1024 + (col - 512)); *(f32x4*)p = v0; *(f32x4*)(p + 4) = v1; }
                    if (plt && t >= 8177) { float* p = pool_out + ((size_t)(b * 15 + (t - 8177)) * 512 + (col - 1536)); *(f32x4*)p = v0; *(f32x4*)(p + 4) = v1; } } }
    }
};
struct EpiUp {
    static constexpr bool PERM = true, AFTER_DRAIN = false;
    int l;
    __device__ __forceinline__ void operator()(const f32x4 (&acc)[2][2][4][2], const Unit& u, int wr, int wc, int fr, int fq) const {
        asm volatile("" : "+v"(fr), "+v"(fq));
        unsigned char* ws = KWS();
        bf16_t* O = (bf16_t*)(ws + WS_ACT); const float* ss = (const float*)(ws + WS_SS) + (size_t)M * 4;
        const int row0 = u.pm * BM + wr * 64 + fr, col0 = u.pn * BM + wc * 32 + 8 * fq;
#pragma unroll
        for (int ai = 0; ai < 2; ++ai)
#pragma unroll
            for (int m = 0; m < 4; ++m) { const int row = row0 + ai * HALF + m * 16;
                const float rs = row_rstd(ss, row);
#pragma unroll
                for (int bj = 0; bj < 2; ++bj) {
                    f32x4 v0 = acc[ai][bj][m][0] * rs, v1 = acc[ai][bj][m][1] * rs;
#pragma unroll
                    for (int e = 0; e < 4; ++e) { const float a = fmaxf(v0[e], 0.f), c = fmaxf(v1[e], 0.f); v0[e] = a * a; v1[e] = c * c; }
                    const u32x4 pk = pack8(v0, v1);
#ifdef REP_EPI4
                    for (int rep = 0; rep < REP_EPI4; ++rep) { asm volatile("" ::: "memory"); *(u32x4*)(O + (size_t)row * 4096 + col0 + bj * HALF) = pk; }
#else
                    *(u32x4*)(O + (size_t)row * 4096 + col0 + bj * HALF) = pk;
#endif
                    } }
    }
};
__device__ __forceinline__ void ss_finish(PG8_LAS unsigned char* lds, float* ssout, const Unit& u) {
    asm volatile("s_waitcnt lgkmcnt(0)" ::: "memory"); __builtin_amdgcn_s_barrier(); asm volatile("" ::: "memory");
    if (threadIdx.x < 256) { const f32x4 p = *(const PG8_LAS f32x4*)(lds + threadIdx.x * 16); ssout[(size_t)(u.pm * BM + threadIdx.x) * 4 + u.pn] = (p[0] + p[1]) + (p[2] + p[3]); }
}
struct EpiRes {
    static constexpr bool PERM = true, AFTER_DRAIN = true;
    int l, which, dummy;
    __device__ __forceinline__ void fused(f32x4 (&acc)[2][2][4][2], const Unit& u, int wr, int wc, int fr, int fq, PG8_LAS unsigned char* lds, int wid, int lane) const {
        asm volatile("" : "+v"(fr), "+v"(fq));
        unsigned char* ws = KWS();
        const bf16_t* base = (const bf16_t*)(ws + ((l & 1) ? WS_HB1 : WS_HB0)); bf16_t* hb = dummy ? (bf16_t*)(ws + WS_H) : (bf16_t*)(ws + ((l & 1) ? WS_HB1 : WS_HB0));
        float* ssout = (float*)(ws + WS_SS) + (size_t)(1 + which) * M * 4;
        PG8_LAS float* P = (PG8_LAS float*)lds;
        const int row0 = u.pm * BM + wr * 64 + fr, col0 = u.pn * BM + wc * 32 + 8 * fq;
#pragma unroll
        for (int ai = 0; ai < 2; ++ai)
#pragma unroll
            for (int m = 0; m < 4; ++m) { const size_t off = (size_t)(row0 + ai * HALF + m * 16) * 1024 + col0; float q = 0.f;
#pragma unroll
                for (int bj = 0; bj < 2; ++bj) {
                    f32x4 b0, b1; unpack8(*(const u32x4*)(base + off + bj * HALF), b0, b1);
                    const f32x4 o0 = b0 + acc[ai][bj][m][0], o1 = b1 + acc[ai][bj][m][1];
                    *(u32x4*)(hb + off + bj * HALF) = pack8(o0, o1);
                    q += dot4(o0) + dot4(o1); }
                q += __shfl_xor(q, 16); q += __shfl_xor(q, 32);
                if (fq == 0) P[(ai * HALF + wr * 64 + m * 16 + fr) * 4 + wc] = q; }
        ss_finish(lds, ssout, u);
    }
};
struct EpiGate {
    static constexpr bool PERM = true, AFTER_DRAIN = true;
    int l, dummy;
    __device__ __forceinline__ void fused(f32x4 (&acc)[2][2][4][2], const Unit& u, int wr, int wc, int fr, int fq, PG8_LAS unsigned char* lds, int wid, int lane) const {
        asm volatile("" : "+v"(fr), "+v"(fq));
        unsigned char* ws = KWS();
        const bf16_t* base = (const bf16_t*)(ws + ((l & 1) ? WS_HB1 : WS_HB0)); bf16_t* hb = dummy ? (bf16_t*)(ws + WS_H) : (bf16_t*)(ws + ((l & 1) ? WS_HB0 : WS_HB1)); const bf16_t* pe = (const bf16_t*)(ws + WS_PE);
        const float* ssin = (const float*)(ws + WS_SS) + (size_t)2 * M * 4; float* ssout = (float*)(ws + WS_SS);
        PG8_LAS float* P = (PG8_LAS float*)lds;
        const int row0 = u.pm * BM + wr * 64 + fr, col0 = u.pn * BM + wc * 32 + 8 * fq;
#pragma unroll
        for (int ai = 0; ai < 2; ++ai)
#pragma unroll
            for (int m = 0; m < 4; ++m) { const int row = row0 + ai * HALF + m * 16; const size_t off = (size_t)row * 1024 + col0; float q = 0.f;
                const float rs = row_rstd(ssin, row);
#pragma unroll
                for (int bj = 0; bj < 2; ++bj) {
                    f32x4 p0, p1, b0, b1; unpack8(*(const u32x4*)(pe + off + bj * HALF), p0, p1); unpack8(*(const u32x4*)(base + off + bj * HALF), b0, b1);
                    f32x4 g0 = acc[ai][bj][m][0] * (rs * -1.4426950408889634f), g1 = acc[ai][bj][m][1] * (rs * -1.4426950408889634f);
#pragma unroll
                    for (int e = 0; e < 4; ++e) { g0[e] = __builtin_amdgcn_rcpf(1.0f + __builtin_amdgcn_exp2f(g0[e])); g1[e] = __builtin_amdgcn_rcpf(1.0f + __builtin_amdgcn_exp2f(g1[e])); }
                    const f32x4 o0 = b0 + p0 * g0, o1 = b1 + p1 * g1;
                    *(u32x4*)(hb + off + bj * HALF) = pack8(o0, o1);
                    q += dot4(o0) + dot4(o1); }
                q += __shfl_xor(q, 16); q += __shfl_xor(q, 32);
                if (fq == 0) P[(ai * HALF + wr * 64 + m * 16 + fr) * 4 + wc] = q; }
        ss_finish(lds, ssout, u);
    }
};

template <class Epi, class Sched, bool ALIGN_EPI = false, bool SP2 = false>
__device__ __forceinline__ void gemm_phase(PG8_LAS unsigned char* lds, const Gemm g, const Sched& S, const Epi& E, int wave_id) {
    int lane = (int)__builtin_amdgcn_mbcnt_hi(~0u, __builtin_amdgcn_mbcnt_lo(~0u, 0u)), widv = wave_id; asm volatile("" : "+v"(lane), "+v"(widv)); const int wid = __builtin_amdgcn_readfirstlane(widv);
    const int tid = wid * 64 + lane, wr = wid >> 2, wc = wid & 3, fr = lane & 15, fq = lane >> 4;
    const int K = g.K, nt = K / BK;
    unsigned voffA[2], voffB[2];
#pragma unroll
    for (int i = 0; i < 2; ++i) { int R, C; stage_rc(tid * 16 + i * 8192, R, C); const int Rb = Epi::PERM ? ((R & ~31) + perm32(R & 31)) : R;
        voffA[i] = (unsigned)(R * K + C) * 2u; voffB[i] = (unsigned)(Rb * K + C) * 2u; }
    const size_t kstep = (size_t)(BK * 2);
    const size_t hstep = (size_t)HALF * K * 2;
    const size_t tstep = 2 * hstep;
    const unsigned ldsw = (unsigned)wid * 1024u;
    const int aoff = lds_byte(wr * 64 + fr, fq * 8), boff = lds_byte(wc * 32 + fr, fq * 8);
#define PG8_SA(b, h) (((b) * 2 + (h)) * HTB)
#define PG8_SB(b, h) ((4 + (b) * 2 + (h)) * HTB)
#define PG8_STAGE(bufoff, gbase, voff) do { _Pragma("unroll") for (int _i = 0; _i < 2; ++_i) \
        __builtin_amdgcn_global_load_lds((const unsigned*)((const char*)(gbase) + (voff)[_i]), (PG8_LAS unsigned*)(lds + (bufoff) + ldsw + _i * 8192), 16, 0, 0); } while (0)
#define PG8_LDA(dst, b, h) do { _Pragma("unroll") for (int m = 0; m < 4; ++m) _Pragma("unroll") for (int k = 0; k < 2; ++k) dst[m][k] = *(const PG8_LAS bf16x8*)(lds + PG8_SA(b, h) + aoff + m * 2048 + k * 1024); } while (0)
#define PG8_LDB(dst, b, h) do { _Pragma("unroll") for (int n = 0; n < 2; ++n) _Pragma("unroll") for (int k = 0; k < 2; ++k) dst[n][k] = *(const PG8_LAS bf16x8*)(lds + PG8_SB(b, h) + boff + n * 2048 + k * 1024); } while (0)
#define PG8_MMA(ai, bj, At, Bt) do { __builtin_amdgcn_s_setprio(1); _Pragma("unroll") for (int m = 0; m < 4; ++m) _Pragma("unroll") for (int n = 0; n < 2; ++n) _Pragma("unroll") for (int k = 0; k < 2; ++k) \
        acc[ai][bj][m][n] = __builtin_amdgcn_mfma_f32_16x16x32_bf16(Bt[n][k], At[m][k], acc[ai][bj][m][n], 0, 0, 0); __builtin_amdgcn_s_setprio(0); } while (0)
#define PG8_WAIT_V(n) asm volatile("s_waitcnt vmcnt(" #n ")" ::: "memory")
#define PG8_WAIT_L(n) asm volatile("s_waitcnt lgkmcnt(" #n ")" ::: "memory")
#define PG8_BAR __builtin_amdgcn_s_barrier()
#define PG8_SCHED __builtin_amdgcn_sched_barrier(0)
    Unit cur, nxt; int ui = 0;
    if (!S.next(0, cur)) return;
    f32x4 acc[2][2][4][2];
#pragma unroll
    for (int a = 0; a < 2; ++a)
#pragma unroll
        for (int b = 0; b < 2; ++b)
#pragma unroll
            for (int m = 0; m < 4; ++m)
#pragma unroll
                for (int n = 0; n < 2; ++n) acc[a][b][m][n] = (f32x4){0.f, 0.f, 0.f, 0.f};
    bf16x8 At[4][2], B0[2][2], B1[2][2];
    const char* cA = (const char*)g.A + (size_t)cur.pm * tstep; const char* cB = (const char*)g.Bt + (size_t)cur.pn * tstep;
    S.a_ready(cur);
    if constexpr (SP2) {
        PG8_STAGE(PG8_SB(0, 0), cB, voffB); PG8_STAGE(PG8_SB(0, 1), cB + hstep, voffB); PG8_STAGE(PG8_SA(0, 0), cA, voffA); PG8_STAGE(PG8_SA(0, 1), cA + hstep, voffA);
        if (wr == 1) PG8_BAR;
        PG8_WAIT_V(2); PG8_BAR;
        PG8_STAGE(PG8_SB(1, 0), cB + kstep, voffB); PG8_STAGE(PG8_SA(1, 0), cA + kstep, voffA); PG8_STAGE(PG8_SB(1, 1), cB + hstep + kstep, voffB);
        PG8_WAIT_V(6); PG8_BAR;
    } else {
        PG8_STAGE(PG8_SB(0, 0), cB, voffB); PG8_STAGE(PG8_SA(0, 0), cA, voffA); PG8_STAGE(PG8_SB(0, 1), cB + hstep, voffB); PG8_STAGE(PG8_SA(0, 1), cA + hstep, voffA);
        if (wr == 1) PG8_BAR;
        PG8_WAIT_V(4); PG8_BAR;
        PG8_STAGE(PG8_SB(1, 0), cB + kstep, voffB); PG8_STAGE(PG8_SA(1, 0), cA + kstep, voffA); PG8_STAGE(PG8_SB(1, 1), cB + hstep + kstep, voffB);
        PG8_WAIT_V(6); PG8_BAR;
    }
    for (;;) {
        const bool has_next = S.next(ui + 1, nxt);
        const char* nA = has_next ? (const char*)g.A + (size_t)nxt.pm * tstep : cA; const char* nB = has_next ? (const char*)g.Bt + (size_t)nxt.pn * tstep : cB;
        for (int t = 0; t < nt; t += 2) {
            const bool last = (t == nt - 2);
            const char* a1 = cA + (size_t)(t + 1) * kstep;
            const char* a2 = last ? nA : cA + (size_t)(t + 2) * kstep; const char* b2 = last ? nB : cB + (size_t)(t + 2) * kstep;
            const char* a3 = a2 + kstep; const char* b3 = b2 + kstep;
            if (last && has_next) S.a_ready(nxt);
            if constexpr (SP2) {
            PG8_LDB(B0, 0, 0); PG8_LDB(B1, 0, 1); PG8_SCHED; PG8_LDA(At, 0, 0); PG8_STAGE(PG8_SA(1, 1), a1 + hstep, voffA);
            PG8_WAIT_V(8); PG8_WAIT_L(0); PG8_BAR; PG8_MMA(0, 0, At, B0); PG8_MMA(0, 1, At, B1); PG8_BAR; PG8_SCHED;
            PG8_LDA(At, 0, 1); PG8_STAGE(PG8_SB(0, 0), b2, voffB); PG8_STAGE(PG8_SB(0, 1), b2 + hstep, voffB); PG8_STAGE(PG8_SA(0, 0), a2, voffA);
            PG8_WAIT_V(8); PG8_WAIT_L(0); PG8_BAR; PG8_MMA(1, 0, At, B0); PG8_MMA(1, 1, At, B1); PG8_BAR; PG8_SCHED;
            PG8_LDB(B0, 1, 0); PG8_LDB(B1, 1, 1); PG8_SCHED; PG8_LDA(At, 1, 0); PG8_STAGE(PG8_SA(0, 1), a2 + hstep, voffA);
            PG8_WAIT_V(8); PG8_WAIT_L(0); PG8_BAR; PG8_MMA(0, 0, At, B0); PG8_MMA(0, 1, At, B1); PG8_BAR; PG8_SCHED;
            PG8_LDA(At, 1, 1); PG8_STAGE(PG8_SB(1, 0), b3, voffB); PG8_STAGE(PG8_SB(1, 1), b3 + hstep, voffB); PG8_STAGE(PG8_SA(1, 0), a3, voffA);
            PG8_WAIT_V(8); PG8_WAIT_L(0); PG8_BAR; PG8_MMA(1, 0, At, B0); PG8_MMA(1, 1, At, B1); PG8_BAR; PG8_SCHED;
            } else {
            PG8_LDB(B0, 0, 0); PG8_SCHED; PG8_LDA(At, 0, 0); PG8_STAGE(PG8_SA(1, 1), a1 + hstep, voffA);
            PG8_WAIT_L(8); PG8_BAR; PG8_WAIT_L(0); PG8_MMA(0, 0, At, B0); PG8_BAR; PG8_SCHED;
            PG8_LDB(B1, 0, 1); PG8_STAGE(PG8_SB(0, 0), b2, voffB);
            PG8_BAR; PG8_WAIT_L(0); PG8_MMA(0, 1, At, B1); PG8_BAR;
            PG8_LDA(At, 0, 1); PG8_STAGE(PG8_SA(0, 0), a2, voffA);
            PG8_BAR; PG8_WAIT_L(0); PG8_MMA(1, 0, At, B0); PG8_BAR; PG8_SCHED;
            PG8_STAGE(PG8_SB(0, 1), b2 + hstep, voffB);
            PG8_WAIT_V(6); PG8_BAR; PG8_MMA(1, 1, At, B1); PG8_BAR;
            PG8_LDB(B0, 1, 0); PG8_SCHED; PG8_LDA(At, 1, 0); PG8_STAGE(PG8_SA(0, 1), a2 + hstep, voffA);
            PG8_WAIT_L(8); PG8_BAR; PG8_WAIT_L(0); PG8_MMA(0, 0, At, B0); PG8_BAR; PG8_SCHED;
            PG8_LDB(B1, 1, 1); PG8_STAGE(PG8_SB(1, 0), b3, voffB);
            PG8_BAR; PG8_WAIT_L(0); PG8_MMA(0, 1, At, B1); PG8_BAR;
            PG8_LDA(At, 1, 1); PG8_STAGE(PG8_SA(1, 0), a3, voffA);
            PG8_BAR; PG8_WAIT_L(0); PG8_MMA(1, 0, At, B0); PG8_BAR; PG8_SCHED;
            PG8_STAGE(PG8_SB(1, 1), b3 + hstep, voffB);
            PG8_WAIT_V(6); PG8_BAR; PG8_MMA(1, 1, At, B1); PG8_BAR;
            }
        }
        if constexpr (ALIGN_EPI) { if (wr == 0) PG8_BAR; }
        if constexpr (!Epi::AFTER_DRAIN) { E(acc, cur, wr, wc, fr, fq); S.done(cur); }
        if (!has_next) break;
#pragma unroll
        for (int a = 0; a < 2; ++a)
#pragma unroll
            for (int b = 0; b < 2; ++b)
#pragma unroll
                for (int m = 0; m < 4; ++m)
#pragma unroll
                    for (int n = 0; n < 2; ++n) acc[a][b][m][n] = (f32x4){0.f, 0.f, 0.f, 0.f};
        cur = nxt; cA = nA; cB = nB; ++ui;
        if constexpr (ALIGN_EPI) { if (wr == 1) PG8_BAR; }
    }
    PG8_WAIT_V(0);
    if constexpr (!ALIGN_EPI) { if (wr == 0) PG8_BAR; }
    PG8_BAR;
    if constexpr (Epi::AFTER_DRAIN) { E.fused(acc, cur, wr, wc, fr, fq, lds, wid, lane); S.done(cur); }
#undef PG8_SA
#undef PG8_SB
#undef PG8_STAGE
#undef PG8_LDA
#undef PG8_LDB
#undef PG8_MMA
#undef PG8_WAIT_V
#undef PG8_WAIT_L
#undef PG8_BAR
#undef PG8_SCHED
}
}
#define XB_TMO      128
#define XB_XCNT(j)  (256  + 64 * (j))
#define XB_XSUB(j)  (1280 + 64 * (j))
#define XB_XGEN(j)  (2304 + 64 * (j))
#define XB_TOP      3328
#define XB_TOPGEN   3392
#define XCD_BAR_WORDS 3456
#define XB_SPIN_CAP (1u << 18)

__device__ __forceinline__ unsigned xb_ld(unsigned* p)              { return __hip_atomic_load(p, __ATOMIC_RELAXED, __HIP_MEMORY_SCOPE_AGENT); }
__device__ __forceinline__ unsigned xb_add(unsigned* p, unsigned v) { return __hip_atomic_fetch_add(p, v, __ATOMIC_RELAXED, __HIP_MEMORY_SCOPE_AGENT); }
__device__ __forceinline__ unsigned xb_xcc_id() { return (unsigned)__builtin_amdgcn_s_getreg((3 << 11) | 20) & 0xFu; }
#define XB_SPIN(cond, bar) do { unsigned _sp = 0; while (cond) { __builtin_amdgcn_s_sleep(1); \
    if ((++_sp & 255u) == 0u) { if (xb_ld(&(bar)[XB_TMO])) break; if (_sp > XB_SPIN_CAP) { atomicAdd(&(bar)[XB_TMO], 1u); break; } } } } while (0)

struct XcdBarrier {
    unsigned* bar; unsigned x;
    volatile LAS unsigned* st;
};

__device__ __forceinline__ XcdBarrier xcd_barrier_post(unsigned* bar, volatile LAS unsigned* st) {
    XcdBarrier b; b.bar = bar; b.x = xb_xcc_id(); b.st = st;
    if (threadIdx.x == 0) (void)xb_add(&bar[XB_XCNT(b.x)], 1u);
    return b;
}
__device__ __forceinline__ void xcd_barrier_complete(unsigned* bar, unsigned x, unsigned& nloc, unsigned& nx) {
    const unsigned G = gridDim.x * gridDim.y * gridDim.z;
    unsigned sum, cnt, mine, sp = 0u;
    for (;;) {
        sum = 0u; cnt = 0u; mine = 0u;
#pragma unroll
        for (unsigned j = 0; j < 16; ++j) { const unsigned c = xb_ld(&bar[XB_XCNT(j)]); sum += c; cnt += (c > 0u) ? 1u : 0u; mine = (j == x) ? c : mine; }
        if (sum == G) break;
        __builtin_amdgcn_s_sleep(1);
        if ((++sp & 255u) == 0u) { if (xb_ld(&bar[XB_TMO])) break; if (sp > XB_SPIN_CAP) { atomicAdd(&bar[XB_TMO], 1u); break; } }
    }
    nloc = mine > 0u ? mine : 1u; nx = cnt > 0u ? cnt : 1u;
}

__device__ __forceinline__ void xcd_barrier(const XcdBarrier& b) {
    asm volatile("s_waitcnt vmcnt(0)" ::: "memory");
    __syncthreads();
    if (threadIdx.x == 0) {
        unsigned* bar = b.bar;
        __builtin_amdgcn_s_waitcnt(0);
        unsigned nloc = b.st[0], nx = b.st[1];
        if (nloc == 0u) { xcd_barrier_complete(bar, b.x, nloc, nx); b.st[0] = nloc; b.st[1] = nx; }
        const unsigned old = xb_add(&bar[XB_XSUB(b.x)], 1u);
        const unsigned gen = old / nloc;
        if (old + 1u == (gen + 1u) * nloc) {
            __builtin_amdgcn_fence(__ATOMIC_RELEASE, "agent");
            asm volatile("s_waitcnt vmcnt(0)" ::: "memory");
            const unsigned og = xb_add(&bar[XB_TOP], 1u);
            const unsigned tg = og / nx;
            if (og + 1u == (tg + 1u) * nx) xb_add(&bar[XB_TOPGEN], 1u);
            else XB_SPIN(xb_ld(&bar[XB_TOPGEN]) == tg, bar);
            __builtin_amdgcn_fence(__ATOMIC_ACQUIRE, "agent");
            xb_add(&bar[XB_XGEN(b.x)], 1u);
            asm volatile("s_waitcnt vmcnt(0)" ::: "memory");
        } else {
            XB_SPIN(xb_ld(&bar[XB_XGEN(b.x)]) == gen, bar);
            __builtin_amdgcn_fence(__ATOMIC_ACQUIRE, "agent");
            asm volatile("s_waitcnt vmcnt(0)" ::: "memory");
        }
    }
    __syncthreads();
}

__device__ __forceinline__ void tr_item(const float* __restrict__ W, int N, const float* __restrict__ g, bf16* __restrict__ WT, int ldk, LAS float* scr, int item, int lane) {
    const int nblk = N >> 5, kb = item / nblk, nb = item - kb * nblk, k0 = kb << 6, n0 = nb << 5;
    const float* src = W + (size_t)(k0 + (lane >> 5)) * N + n0 + (lane & 31);
    float v[32];
#pragma unroll
    for (int i = 0; i < 32; ++i) v[i] = src[(size_t)(2 * i) * N];
    if (g) {
#pragma unroll
        for (int i = 0; i < 32; ++i) v[i] *= g[k0 + 2 * i + (lane >> 5)];
    }
#pragma unroll
    for (int i = 0; i < 32; ++i) scr[(2 * i + (lane >> 5)) * 33 + (lane & 31)] = v[i];
    LDS_WAIT(); asm volatile("" ::: "memory");
    const int c = lane & 7;
#pragma unroll
    for (int j = 0; j < 4; ++j) { const int n = (lane >> 3) + 8 * j; const LAS float* s = scr + (8 * c) * 33 + n;
        v4u o; o.x = pk2(s[0 * 33], s[1 * 33]); o.y = pk2(s[2 * 33], s[3 * 33]); o.z = pk2(s[4 * 33], s[5 * 33]); o.w = pk2(s[6 * 33], s[7 * 33]);
        *(v4u*)(WT + (size_t)(n0 + n) * ldk + k0 + 8 * c) = o; }
    LDS_WAIT(); asm volatile("" ::: "memory");
}
__device__ __forceinline__ void fold_item(const float* __restrict__ pw, const float* __restrict__ scale, const float* __restrict__ wout, bf16* __restrict__ WT, LAS float* scr, int item, int lane) {
    const int kb = item >> 4, nb = item & 15, kp0 = kb << 5, g = kp0 >> 7, c0 = kp0 & 127, n = (nb << 6) + lane;
    const f32x4* psrc = (const f32x4*)(pw + (size_t)(g * 128 + c0) * 128);
#pragma unroll
    for (int i = 0; i < 16; ++i) *(LAS f32x4*)(scr + (i * 64 + lane) * 4) = psrc[i * 64 + lane];
    LDS_WAIT(); asm volatile("" ::: "memory");
    const float* wsrc = wout + (size_t)(512 + g * 128) * 1024 + n;
    const float* ssrc = scale + g * 128;
    float acc[32];
#pragma unroll
    for (int i = 0; i < 32; ++i) acc[i] = 0.f;
    for (int d4 = 0; d4 < 32; ++d4) {
        const f32x4 s4 = *(const f32x4*)(ssrc + 4 * d4);
        const float v0 = wsrc[(size_t)(4 * d4 + 0) * 1024] * s4[0], v1 = wsrc[(size_t)(4 * d4 + 1) * 1024] * s4[1], v2 = wsrc[(size_t)(4 * d4 + 2) * 1024] * s4[2], v3 = wsrc[(size_t)(4 * d4 + 3) * 1024] * s4[3];
#pragma unroll
        for (int i = 0; i < 32; ++i) { const f32x4 p = *(const LAS f32x4*)(scr + i * 128 + 4 * d4); acc[i] += (p[0] * v0 + p[1] * v1) + (p[2] * v2 + p[3] * v3); }
    }
    v4u* dst = (v4u*)(WT + (size_t)n * 1024 + 512 + kp0);
#pragma unroll
    for (int j = 0; j < 4; ++j) { v4u o; o.x = pk2(acc[8 * j], acc[8 * j + 1]); o.y = pk2(acc[8 * j + 2], acc[8 * j + 3]); o.z = pk2(acc[8 * j + 4], acc[8 * j + 5]); o.w = pk2(acc[8 * j + 6], acc[8 * j + 7]); dst[j] = o; }
    LDS_WAIT(); asm volatile("" ::: "memory");
}
__device__ __forceinline__ void xrow_item(const float* __restrict__ xrow, bf16* __restrict__ orow, float* __restrict__ ssrow, int nss, float* __restrict__ copy, int lane) {
    const f32x4* xr = (const f32x4*)xrow + lane;
    f32x4 v[4]; float s = 0.f;
#pragma unroll
    for (int j = 0; j < 4; ++j) { v[j] = xr[64 * j]; s += (v[j][0] * v[j][0] + v[j][1] * v[j][1]) + (v[j][2] * v[j][2] + v[j][3] * v[j][3]); }
    s = wave_sum(s);
    v2u* o8 = (v2u*)orow + lane;
#pragma unroll
    for (int j = 0; j < 4; ++j) { v2u o; o.x = pk2(v[j][0], v[j][1]); o.y = pk2(v[j][2], v[j][3]); o8[64 * j] = o; }
    if (copy) {
#pragma unroll
        for (int j = 0; j < 4; ++j) ((f32x4*)copy + lane)[64 * j] = v[j];
    }
    if (lane < nss) ssrow[lane] = (lane == 0) ? s : 0.f;
}
__device__ __forceinline__ void xrow2_item(const float* __restrict__ xrow, bf16* __restrict__ orow, float* __restrict__ ssrow, size_t dr, int lane) {
    f32x4 v[2][4]; float s[2] = {0.f, 0.f};
#pragma unroll
    for (int r = 0; r < 2; ++r)
#pragma unroll
        for (int j = 0; j < 4; ++j) v[r][j] = ((const f32x4*)(xrow + r * dr * D) + lane)[64 * j];
#pragma unroll
    for (int r = 0; r < 2; ++r) {
#pragma unroll
        for (int j = 0; j < 4; ++j) s[r] += (v[r][j][0] * v[r][j][0] + v[r][j][1] * v[r][j][1]) + (v[r][j][2] * v[r][j][2] + v[r][j][3] * v[r][j][3]);
        s[r] = wave_sum(s[r]);
        v2u* o8 = (v2u*)(orow + r * dr * D) + lane;
#pragma unroll
        for (int j = 0; j < 4; ++j) { v2u o; o.x = pk2(v[r][j][0], v[r][j][1]); o.y = pk2(v[r][j][2], v[r][j][3]); o8[64 * j] = o; }
        if (lane < 4) ssrow[r * dr * 4 + lane] = (lane == 0) ? s[r] : 0.f;
    }
}
__device__ __forceinline__ void cvt_item4(const float* __restrict__ src, bf16* __restrict__ dst, int item, int lane) {
    const size_t idx = (size_t)item * 2048 + lane * 8;
    f32x4 a[4], b[4];
#pragma unroll
    for (int j = 0; j < 4; ++j) { a[j] = *(const f32x4*)(src + idx + 512 * j); b[j] = *(const f32x4*)(src + idx + 512 * j + 4); }
#pragma unroll
    for (int j = 0; j < 4; ++j) { v4u o; o.x = pk2(a[j][0], a[j][1]); o.y = pk2(a[j][2], a[j][3]); o.z = pk2(b[j][0], b[j][1]); o.w = pk2(b[j][2], b[j][3]); *(v4u*)(dst + idx + 512 * j) = o; }
}
__device__ __forceinline__ void final_row(const float* __restrict__ hrow, float rstd, const float* __restrict__ gf, float* __restrict__ yrow, int lane) {
#pragma unroll
    for (int j = 0; j < 4; ++j) { const f32x4 v = ((const f32x4*)hrow + lane)[64 * j], gg = ((const f32x4*)gf + lane)[64 * j]; ((f32x4*)yrow + lane)[64 * j] = v * rstd * gg; }
}

__device__ __forceinline__ void final_row_bf(const bf16* __restrict__ hrow, float rstd, const float* __restrict__ gf, float* __restrict__ yrow, int lane) {
#pragma unroll
    for (int j = 0; j < 2; ++j) { const v4u x = ((const v4u*)hrow + lane)[64 * j]; const f32x4 g0 = ((const f32x4*)gf)[(64 * j + lane) * 2], g1 = ((const f32x4*)gf)[(64 * j + lane) * 2 + 1];
        f32x4 a = {bflo(x.x), bfhi(x.x), bflo(x.y), bfhi(x.y)}, b = {bflo(x.z), bfhi(x.z), bflo(x.w), bfhi(x.w)};
        ((f32x4*)yrow)[(64 * j + lane) * 2] = a * rstd * g0; ((f32x4*)yrow)[(64 * j + lane) * 2 + 1] = b * rstd * g1; }
}

__device__ __forceinline__ int crow(int i, int hi) { return (i & 3) + 8 * (i >> 2) + 4 * hi; }
__device__ __forceinline__ s16x4 vtr(LAS unsigned char* p) { typedef short v4i16_t __attribute__((ext_vector_type(4))); return __builtin_bit_cast(s16x4, __builtin_amdgcn_ds_read_tr16_b64_v4i16((LAS v4i16_t*)p)); }
__device__ __forceinline__ unsigned cvtpk(float lo, float hi) { typedef float f2 __attribute__((ext_vector_type(2))); typedef __bf16 b2 __attribute__((ext_vector_type(2))); f2 v = {lo, hi}; b2 b = __builtin_convertvector(v, b2); return __builtin_bit_cast(unsigned, b); }
__device__ __forceinline__ void glds16(const void* gsrc, unsigned lds_dst) { unsigned keep;
    asm volatile("s_mov_b32 %0, m0\n\ts_mov_b32 m0, %2\n\ts_nop 0\n\tglobal_load_lds_dwordx4 %1, off\n\ts_mov_b32 m0, %0" : "=&s"(keep) : "v"(gsrc), "s"(lds_dst) : "memory"); }
#define VMW(n) asm volatile("s_waitcnt vmcnt(" #n ")" ::: "memory")
__device__ __forceinline__ void attn_tile(const bf16* __restrict__ X  , int h, int dsh, int r, int c0, LAS unsigned char* wst  ,
                                          bf16* __restrict__ OP  , float* __restrict__ LS  , int lane) {
    asm volatile("" : "+v"(lane));
    const int r32 = lane & 31, hi = lane >> 5;
    const int nskip = (c0 < 128) ? ((128 - c0) >> 5) : 0;
    const float NEG = -1e30f;
    LAS unsigned char* kst = wst; LAS unsigned char* vst = wst + 8192;
    const unsigned kst_a = (unsigned)__builtin_amdgcn_readfirstlane((int)(size_t)kst), vst_a = kst_a + 8192u;
    const int krow8 = lane >> 3, vrow8 = (lane >> 2) & 7;
    const bf16* kcol = X + (size_t)r * QP + h * 64;
    const bf16* vcol = X + (size_t)r * QP + 1024 + h * 64 + 8 * ((lane & 3) + 4 * (lane >> 5));
#define DMA_K(blk, slot) do { _Pragma("unroll") for (int i_ = 0; i_ < 4; ++i_) { const int row_ = 8 * i_ + krow8; int kc_ = c0 - 128 + 32 * (blk) + row_; kc_ = kc_ < 0 ? 0 : kc_; \
        glds16(kcol + 512 + ((size_t)kc_ << dsh) * QP + 8 * ((lane & 7) ^ ((row_ >> 1) & 7)), kst_a + (slot) * 4096u + i_ * 1024u); } } while (0)
#define DMA_V(blk, slot) do { _Pragma("unroll") for (int i_ = 0; i_ < 4; ++i_) { int kc_ = c0 - 128 + 32 * (blk) + 8 * i_ + vrow8; kc_ = kc_ < 0 ? 0 : kc_; \
        glds16(vcol + ((size_t)kc_ << dsh) * QP, vst_a + (slot) * 4096u + i_ * 1024u); } } while (0)
#pragma unroll
    for (int i = 0; i < 4; ++i) { const int row = 8 * i + krow8; glds16(kcol + ((size_t)(c0 + row) << dsh) * QP + 8 * ((lane & 7) ^ ((row >> 1) & 7)), vst_a + 4096u + i * 1024u); }
    DMA_K(0, 0); DMA_K(1, 1); DMA_V(0, 0);
    const int fsw = (r32 >> 1) & 7;
    bf16x8 qf[4];
    VMW(12);
#pragma unroll
    for (int ds = 0; ds < 4; ++ds) qf[ds] = *(const LAS bf16x8*)(vst + 4096 + r32 * 128 + 16 * ((2 * ds + hi) ^ fsw));
    LDS_WAIT(); asm volatile("" ::: "memory");
    DMA_V(1, 1);
    f32x16 s[5];
#pragma unroll
    for (int blk = 0; blk < 5; ++blk) {
        if (blk < 2) VMW(12); else if (blk < 4) VMW(4); else VMW(0);
        bf16x8 kf[4];
#pragma unroll
        for (int ds = 0; ds < 4; ++ds) kf[ds] = *(const LAS bf16x8*)(kst + (blk & 1) * 4096 + r32 * 128 + 16 * ((2 * ds + hi) ^ fsw));
        LDS_WAIT(); asm volatile("" ::: "memory");
        if (blk + 2 < 5) DMA_K(blk + 2, blk & 1);
        f32x16 a;
#pragma unroll
        for (int i = 0; i < 16; ++i) a[i] = 0.f;
#pragma unroll
        for (int ds = 0; ds < 4; ++ds) a = __builtin_amdgcn_mfma_f32_32x32x16_bf16(kf[ds], qf[ds], a, 0, 0, 0);
        if (blk < 4) {
            const bool dead = blk < nskip;
#pragma unroll
            for (int i = 0; i < 16; ++i) a[i] = dead ? NEG : a[i];
        }
        s[blk] = a;
    }
#pragma unroll
    for (int i = 0; i < 16; ++i) { const int kr = crow(i, hi); if (kr < r32) s[0][i] = NEG; if (kr > r32) s[4][i] = NEG; }
    float m = s[4][0];
#pragma unroll
    for (int blk = 0; blk < 5; ++blk)
#pragma unroll
        for (int i = 0; i < 16; ++i) m = fmaxf(m, s[blk][i]);
    m = fmaxf(m, __shfl_xor(m, 32));
    float l = 0.f;
#pragma unroll
    for (int blk = 0; blk < 5; ++blk)
#pragma unroll
        for (int i = 0; i < 16; ++i) { const float p = __builtin_amdgcn_exp2f(s[blk][i] - m); s[blk][i] = p; l += p; }
    l += __shfl_xor(l, 32);
    f32x16 o[2];
#pragma unroll
    for (int i = 0; i < 16; ++i) { o[0][i] = 0.f; o[1][i] = 0.f; }
    const int vb = (4 * hi + ((lane & 15) >> 2)) * 64 + ((lane >> 4) & 1) * 32 + (lane & 3) * 8;
#pragma unroll
    for (int blk = 0; blk < 5; ++blk) {
        if (blk == 2 || blk == 3) VMW(4); else if (blk == 4) VMW(0);
        LAS unsigned char* buf = vst + (blk & 1) * 4096;
        bf16x8 vf[2][2];
#pragma unroll
        for (int s2 = 0; s2 < 2; ++s2)
#pragma unroll
            for (int d0 = 0; d0 < 2; ++d0) { const s16x4 a = vtr(buf + vb + (2 * s2) * 1024 + d0 * 512), b = vtr(buf + vb + (2 * s2 + 1) * 1024 + d0 * 512); vf[s2][d0] = (bf16x8){a[0], a[1], a[2], a[3], b[0], b[1], b[2], b[3]}; }
        LDS_WAIT(); asm volatile("" ::: "memory");
        if (blk + 2 < 5) DMA_V(blk + 2, blk & 1);
#pragma unroll
        for (int s2 = 0; s2 < 2; ++s2) {
            v4u pw; pw.x = cvtpk(s[blk][8 * s2 + 0], s[blk][8 * s2 + 1]); pw.y = cvtpk(s[blk][8 * s2 + 2], s[blk][8 * s2 + 3]); pw.z = cvtpk(s[blk][8 * s2 + 4], s[blk][8 * s2 + 5]); pw.w = cvtpk(s[blk][8 * s2 + 6], s[blk][8 * s2 + 7]);
            const bf16x8 pf = __builtin_bit_cast(bf16x8, pw);
#pragma unroll
            for (int d0 = 0; d0 < 2; ++d0) o[d0] = __builtin_amdgcn_mfma_f32_32x32x16_bf16(vf[s2][d0], pf, o[d0], 0, 0, 0);
        }
    }
    const float inv = 1.0f / l;
    const int tq = ((c0 + r32) << dsh) + r;
#pragma unroll
    for (int d0 = 0; d0 < 2; ++d0)
#pragma unroll
        for (int gq = 0; gq < 4; ++gq) { v2u w; w.x = cvtpk(o[d0][4 * gq] * inv, o[d0][4 * gq + 1] * inv); w.y = cvtpk(o[d0][4 * gq + 2] * inv, o[d0][4 * gq + 3] * inv);
            *(LAS v2u*)(kst + r32 * 128 + 16 * ((4 * d0 + gq) ^ (r32 & 7)) + 8 * hi) = w; }
    LDS_WAIT(); asm volatile("" ::: "memory");
#pragma unroll
    for (int i = 0; i < 4; ++i) { const int row = 8 * i + krow8; const v4u x = *(const LAS v4u*)(kst + i * 1024 + lane * 16);
        *(v4u*)(OP + (size_t)(((c0 + row) << dsh) + r) * 512 + h * 64 + 8 * ((lane & 7) ^ (row & 7))) = x; }
    LDS_WAIT(); asm volatile("" ::: "memory");
    if (hi == 0) LS[(size_t)tq * 8 + h] = m + __builtin_amdgcn_logf(l);
}
#undef DMA_K
#undef DMA_V
template <int W> __device__ __forceinline__ void z_part(const bf16* __restrict__ ub  , bf16* __restrict__ zb  , int tfirst) {
    v4u rows[W + 7];
#pragma unroll
    for (int k = 0; k < W + 7; ++k) { const int tt = tfirst - (W - 1) + k; const v4u x = *(const v4u*)(ub + (size_t)(tt < 0 ? 0 : tt) * QP); rows[k] = tt < 0 ? (v4u){0u, 0u, 0u, 0u} : x; }
    __builtin_amdgcn_sched_barrier(0);
    float sacc[8];
#pragma unroll
    for (int e = 0; e < 8; ++e) sacc[e] = 0.f;
#pragma unroll
    for (int k = 0; k < W - 1; ++k) { const v4u x = rows[k];
        sacc[0] += bflo(x.x); sacc[1] += bfhi(x.x); sacc[2] += bflo(x.y); sacc[3] += bfhi(x.y); sacc[4] += bflo(x.z); sacc[5] += bfhi(x.z); sacc[6] += bflo(x.w); sacc[7] += bfhi(x.w); }
#pragma unroll
    for (int i = 0; i < 8; ++i) {
        const int t = tfirst + i; const v4u x = rows[W - 1 + i];
        const float u8[8] = {bflo(x.x), bfhi(x.x), bflo(x.y), bfhi(x.y), bflo(x.z), bfhi(x.z), bflo(x.w), bfhi(x.w)};
#pragma unroll
        for (int e = 0; e < 8; ++e) sacc[e] += u8[e];
        const float rc = 1.0f / (float)((t + 1 < W) ? (t + 1) : W);
        v4u oz; oz.x = pk2(sacc[0] * rc - u8[0], sacc[1] * rc - u8[1]); oz.y = pk2(sacc[2] * rc - u8[2], sacc[3] * rc - u8[3]); oz.z = pk2(sacc[4] * rc - u8[4], sacc[5] * rc - u8[5]); oz.w = pk2(sacc[6] * rc - u8[6], sacc[7] * rc - u8[7]);
        *(v4u*)(zb + (size_t)t * 1024) = oz;
        const v4u y = rows[i];
        sacc[0] -= bflo(y.x); sacc[1] -= bfhi(y.x); sacc[2] -= bflo(y.y); sacc[3] -= bfhi(y.y); sacc[4] -= bflo(y.z); sacc[5] -= bfhi(y.z); sacc[6] -= bflo(y.w); sacc[7] -= bfhi(y.w);
    }
}
__device__ __forceinline__ void merge_z_unit(const bf16* __restrict__ QKVU, const bf16* __restrict__ OPART, const float* __restrict__ LSE, bf16* __restrict__ AO, int b, int h, int T0, int tid) {
    const int ch = tid & 7, tg = tid >> 3;
    const size_t rowb = (size_t)b * SEQ;
    const int tfirst = T0 + 8 * tg;
    { float ls[8][3]; v4u a[8][3];
#pragma unroll
      for (int i = 0; i < 8; ++i)
#pragma unroll
        for (int g = 0; g < 3; ++g) { const size_t row = (size_t)g * M + rowb + tfirst + i; ls[i][g] = LSE[row * 8 + h]; a[i][g] = *(const v4u*)(OPART + row * 512 + h * 64 + 8 * ch); }
      __builtin_amdgcn_sched_barrier(0);
#pragma unroll
      for (int i = 0; i < 8; ++i) {
        const float mx = fmaxf(ls[i][0], fmaxf(ls[i][1], ls[i][2]));
        float w0 = __builtin_amdgcn_exp2f(ls[i][0] - mx), w1 = __builtin_amdgcn_exp2f(ls[i][1] - mx), w2 = __builtin_amdgcn_exp2f(ls[i][2] - mx);
        const float inv = 1.0f / (w0 + w1 + w2); w0 *= inv; w1 *= inv; w2 *= inv;
        const v4u a0 = a[i][0], a1 = a[i][1], a2 = a[i][2];
        v4u oa;
        oa.x = pk2(w0 * bflo(a0.x) + w1 * bflo(a1.x) + w2 * bflo(a2.x), w0 * bfhi(a0.x) + w1 * bfhi(a1.x) + w2 * bfhi(a2.x));
        oa.y = pk2(w0 * bflo(a0.y) + w1 * bflo(a1.y) + w2 * bflo(a2.y), w0 * bfhi(a0.y) + w1 * bfhi(a1.y) + w2 * bfhi(a2.y));
        oa.z = pk2(w0 * bflo(a0.z) + w1 * bflo(a1.z) + w2 * bflo(a2.z), w0 * bfhi(a0.z) + w1 * bfhi(a1.z) + w2 * bfhi(a2.z));
        oa.w = pk2(w0 * bflo(a0.w) + w1 * bflo(a1.w) + w2 * bflo(a2.w), w0 * bfhi(a0.w) + w1 * bfhi(a1.w) + w2 * bfhi(a2.w));
        *(v4u*)(AO + (rowb + tfirst + i) * 1024 + h * 64 + 8 * ch) = oa;
      } }
    const bf16* ub = QKVU + rowb * QP + 1536 + h * 64 + 8 * ch; bf16* zb = AO + rowb * 1024 + 512 + h * 64 + 8 * ch;
    const int wsel = h >> 1;
    if (wsel == 0) z_part<2>(ub, zb, tfirst); else if (wsel == 1) z_part<4>(ub, zb, tfirst); else if (wsel == 2) z_part<8>(ub, zb, tfirst); else z_part<16>(ub, zb, tfirst);
}

__device__ __forceinline__ void sample_attn_unit(const float* __restrict__ ckv  , const float* __restrict__ spool  ,
                                                 const float* __restrict__ QS, const float* __restrict__ kvnew  , float* __restrict__ psout  ,
                                                 bf16* __restrict__ AOS, int bs, int h, LAS float* red, int wave, int lane, int tid) {
    const int ks = lane >> 4, d4 = lane & 15;
    const f32x4 q4 = *(const f32x4*)(QS + bs * 512 + h * 64 + 4 * d4);
    const float* cb = ckv + (size_t)bs * 2048 * 1024 + h * 64 + 4 * d4;
    const float* nk = kvnew + bs * 1024 + h * 64 + 4 * d4;
    float sc[13]; f32x4 vv[13];
#pragma unroll
    for (int i = 0; i < 13; ++i) {
        const int idx = wave * 52 + i * 4 + ks; const bool valid = idx < 387;
        const int g = (idx >= 258) ? 2 : ((idx >= 129) ? 1 : 0), j = idx - g * 129;
        const float* kp = (valid && j > 0) ? (cb + (size_t)(2048 - (j << (2 * g))) * 1024) : nk;
        const f32x4 k4 = *(const f32x4*)kp; vv[i] = *(const f32x4*)(kp + 512);
        float d = (q4[0] * k4[0] + q4[1] * k4[1]) + (q4[2] * k4[2] + q4[3] * k4[3]);
        d += __shfl_xor(d, 1); d += __shfl_xor(d, 2); d += __shfl_xor(d, 4); d += __shfl_xor(d, 8);
        sc[i] = valid ? d : -1e30f;
    }
    float m = sc[0];
#pragma unroll
    for (int i = 1; i < 13; ++i) m = fmaxf(m, sc[i]);
    m = fmaxf(m, __shfl_xor(m, 16)); m = fmaxf(m, __shfl_xor(m, 32));
    float l = 0.f; f32x4 o = {0.f, 0.f, 0.f, 0.f};
#pragma unroll
    for (int i = 0; i < 13; ++i) { const float p = __builtin_amdgcn_exp2f(sc[i] - m); l += p; o += vv[i] * p; }
    l += __shfl_xor(l, 16); l += __shfl_xor(l, 32);
#pragma unroll
    for (int e = 0; e < 4; ++e) { o[e] += __shfl_xor(o[e], 16); o[e] += __shfl_xor(o[e], 32); }
    if (ks == 0) *(LAS f32x4*)(red + wave * 68 + 4 * d4) = o;
    if (lane == 0) { red[wave * 68 + 64] = m; red[wave * 68 + 65] = l; }
    __syncthreads();
    if (tid < 64) {
        float mm = red[64];
#pragma unroll
        for (int w = 1; w < 8; ++w) mm = fmaxf(mm, red[w * 68 + 64]);
        float L = 0.f, O = 0.f;
#pragma unroll
        for (int w = 0; w < 8; ++w) { const float f = __builtin_amdgcn_exp2f(red[w * 68 + 64] - mm); L += red[w * 68 + 65] * f; O += red[w * 68 + tid] * f; }
        AOS[bs * 1024 + h * 64 + tid] = (bf16)f2bf(O / L);
    } else if (tid < 128) {
        const int col = h * 64 + (tid - 64); const int w = 2 << (h >> 1);
        const float un = psout[(size_t)(bs * 15 + 14) * 512 + col];
        float s = un;
        for (int j = 1; j < w; ++j) s += spool[(size_t)(bs * 15 + (15 - j)) * 512 + col];
        AOS[bs * 1024 + 512 + col] = (bf16)f2bf(s / (float)w - un);
    } else if (tid < 192) {
        const int col = h * 64 + (tid - 128);
#pragma unroll
        for (int i = 0; i < 14; ++i) psout[(size_t)(bs * 15 + i) * 512 + col] = spool[(size_t)(bs * 15 + i + 1) * 512 + col];
    }
    __syncthreads();
}
template <int K> __device__ __forceinline__ f32x4 sg_tile(const bf16* __restrict__ A, const bf16* __restrict__ Bt, int n0, LAS float* red, int wave, int lane, int tid) {
    constexpr int KW = K / 8;
    f32x4 acc[2][4];
#pragma unroll
    for (int a = 0; a < 2; ++a)
#pragma unroll
        for (int c = 0; c < 4; ++c) acc[a][c] = (f32x4){0.f, 0.f, 0.f, 0.f};
    const int r16 = lane & 15, kq = lane >> 4;
    const bf16* ap = A + (size_t)r16 * K + wave * KW + 8 * kq;
    const bf16* bp = Bt + (size_t)(n0 + r16) * K + wave * KW + 8 * kq;
#pragma unroll 2
    for (int k = 0; k < KW; k += 32) {
        const bf16x8 a0 = *(const bf16x8*)(ap + k), a1 = *(const bf16x8*)(ap + (size_t)16 * K + k);
#pragma unroll
        for (int c = 0; c < 4; ++c) { const bf16x8 bb = *(const bf16x8*)(bp + (size_t)c * 16 * K + k);
            acc[0][c] = __builtin_amdgcn_mfma_f32_16x16x32_bf16(a0, bb, acc[0][c], 0, 0, 0); acc[1][c] = __builtin_amdgcn_mfma_f32_16x16x32_bf16(a1, bb, acc[1][c], 0, 0, 0); }
    }
#pragma unroll
    for (int a = 0; a < 2; ++a)
#pragma unroll
        for (int c = 0; c < 4; ++c)
#pragma unroll
            for (int i = 0; i < 4; ++i) red[(wave * 32 + 16 * a + 4 * kq + i) * 64 + 16 * c + r16] = acc[a][c][i];
    __syncthreads();
    const int row = tid >> 4, c4 = (tid & 15) * 4;
    f32x4 sum = (f32x4){0.f, 0.f, 0.f, 0.f};
#pragma unroll
    for (int w = 0; w < 8; ++w) sum += *(const LAS f32x4*)(red + (w * 32 + row) * 64 + c4);
    return sum;
}
__device__ __forceinline__ float srstd(const float* __restrict__ sss, int row) {
    const f32x4* p = (const f32x4*)(sss + row * 16); const f32x4 a = p[0] + p[1] + p[2] + p[3];
    return __builtin_amdgcn_rsqf(((a[0] + a[1]) + (a[2] + a[3])) * (1.0f / 1024.0f) + 1e-6f);
}
__device__ __forceinline__ void sss_put(float* __restrict__ sss, int row, int task, const f32x4 o, int tid) {
    float q = (o[0] * o[0] + o[1] * o[1]) + (o[2] * o[2] + o[3] * o[3]);
    q += __shfl_xor(q, 1); q += __shfl_xor(q, 2); q += __shfl_xor(q, 4); q += __shfl_xor(q, 8);
    if ((tid & 15) == 0) sss[row * 16 + task] = q;
}

struct Args { const float* in[18]; float* out; unsigned char* ws; int ph_lo, ph_hi; };
#define IN(k) (lo <= (k) && (k) < hi)
#ifndef REP_P0
#define REP_P0 1
#endif
#ifndef REP_P1
#define REP_P1 1
#endif
#ifndef REP_P2
#define REP_P2 1
#endif
#ifndef REP_P2T
#define REP_P2T 1
#endif
#ifndef REP_P2M
#define REP_P2M 1
#endif
#ifndef REP_P2S
#define REP_P2S 1
#endif
#ifndef REP_P4
#define REP_P4 1
#endif
#ifndef REP_P3
#define REP_P3 1
#endif
#ifndef REP_P5
#define REP_P5 1
#endif
#ifndef REP_P6
#define REP_P6 1
#endif
#ifndef REP_PE
#define REP_PE 1
#endif
#ifndef REP_S1
#define REP_S1 1
#endif
#ifndef REP_S4
#define REP_S4 1
#endif
#define SEAM(k) do { if (IN((k) + 1)) { bar.bar = (unsigned*)(KWS() + WS_CTL) + CW_BAR; xcd_barrier(bar); } } while (0)
#define PH_TID() int lane = (int)__builtin_amdgcn_mbcnt_hi(~0u, __builtin_amdgcn_mbcnt_lo(~0u, 0u)); asm volatile("" : "+v"(lane)); const int tid = wave * 64 + lane;
template <int L> __device__ __forceinline__ void layer_phases(LAS unsigned char* lds, const int lo, const int hi, const int G, const int bx, const int wave, XcdBarrier& bar) {
    constexpr int l = L;
    LAS float* red0 = (LAS float*)(lds + RING_OFF); LAS float* red1 = (LAS float*)(lds + RING_OFF + 65536);
        const int pb = 1 + 6 * l;
        if (IN(pb + 0)) {
            PH_TID();
            for (int rep = 0; rep < REP_S1; ++rep)
            if (bx < DIN / 64) {
                unsigned char* ws = KWS(); float* outp = KOUT();
                const bf16* hsbx = (const bf16*)(ws + WS_SMP + ((l & 1) ? SMP_HSB1 : SMP_HSB0));
                for (int t = bx; t < DIN / 64; t += G) {
                    const f32x4 v = sg_tile<D>(hsbx, (const bf16*)(ws + WS_W + l * W_LAYER + W_IN), t * 64, red0, wave, lane, tid) * srstd((const float*)(ws + WS_SMP + SMP_SSS), tid >> 4);
                    const int row = tid >> 4, col = t * 64 + (tid & 15) * 4;
                    if (col < 512) *(f32x4*)((float*)(ws + WS_SMP + SMP_QS) + row * 512 + col) = v * QSCALE;
                    else if (col < 1536) *(f32x4*)(outp + O_KVS + (size_t)l * SB * 1024 + row * 1024 + (col - 512)) = v;
                    else *(f32x4*)(outp + O_PS + (size_t)l * SB * PBUF * DP + (size_t)(row * 15 + 14) * 512 + (col - 1536)) = v;
                    __syncthreads();
                }
            }
            unsigned char* ws = KWS();
            pg8::Gemm g{(const bf16*)(ws + ((l & 1) ? WS_HB1 : WS_HB0)), (const bf16*)(ws + WS_W + l * W_LAYER + W_IN), M, DIN, D}; pg8::StaticOrder S; S.init(M, DIN, G, bx);
            pg8::EpiProj E{l};
            for (int rep = 0; rep < REP_P1; ++rep)
            pg8::gemm_phase<pg8::EpiProj, pg8::StaticOrder, true, true>(lds + RING_OFF, g, S, E, wave);
            SEAM(pb + 0);
        }
        if (IN(pb + 1)) {
            PH_TID();
            { unsigned char* ws = KWS(); float* outp = KOUT();
              const float* cache_kv = KIN(2) + (size_t)l * SB * 2048 * 1024; const float* state_pool = KIN(3) + (size_t)l * SB * PBUF * DP;
              for (int rep = 0; rep < REP_P2S; ++rep)
              for (int su = bx; su < SB * 8; su += G)
                sample_attn_unit(cache_kv, state_pool, (const float*)(ws + WS_SMP + SMP_QS), outp + O_KVS + (size_t)l * SB * 1024, outp + O_PS + (size_t)l * SB * PBUF * DP, (bf16*)(ws + WS_SMP + SMP_AOS), su >> 3, su & 7, red0, wave, lane, tid); }
            { unsigned char* ws = KWS();
              const bf16* QKVU = (const bf16*)(ws + WS_QKVU); bf16* OPART = (bf16*)(ws + WS_OPART); float* LSE = (float*)(ws + WS_LSE);
              for (int rep = 0; rep < REP_P2; ++rep)
              for (int uid = bx; uid < 256; uid += G) {
                const int h = uid & 7, bc = uid >> 3, b = bc >> 4, T0 = (bc & 15) * 512;
                const bf16* X = QKVU + (size_t)b * SEQ * QP;
                LAS unsigned char* vst = lds + RING_OFF + wave * 16384;
                for (int rept = 0; rept < REP_P2T; ++rept)
                for (int tile = wave; tile < 48; tile += 8) {
                    asm volatile("" ::: "memory");
                    const int gp = tile >> 4, idx = tile & 15;
                    int dsh, r, c0;
                    if (gp == 0) { dsh = 0; r = 0; c0 = T0 + 32 * idx; }
                    else if (gp == 1) { dsh = 2; r = idx & 3; c0 = (T0 >> 2) + 32 * (idx >> 2); }
                    else { dsh = 4; r = idx; c0 = T0 >> 4; }
                    attn_tile(X, h, dsh, r, c0, vst, OPART + ((size_t)gp * M + (size_t)b * SEQ) * 512, LSE + ((size_t)gp * M + (size_t)b * SEQ) * 8, lane);
                }
                VM_WAIT(); __syncthreads();
                for (int repm = 0; repm < REP_P2M; ++repm) { asm volatile("" ::: "memory");
                merge_z_unit(QKVU, OPART, LSE, (bf16*)(ws + WS_AO), b, h, T0, tid); }
              } }
            SEAM(pb + 1);
        }
        if (IN(pb + 2)) {
            PH_TID();
            if (bx < D / 64) {
                unsigned char* ws = KWS();
                float* HS = (float*)(ws + WS_SMP + SMP_HS); bf16* hsbx = (bf16*)(ws + WS_SMP + ((l & 1) ? SMP_HSB1 : SMP_HSB0));
                for (int t = bx; t < D / 64; t += G) {
                    const f32x4 s = sg_tile<D>((const bf16*)(ws + WS_SMP + SMP_AOS), (const bf16*)(ws + WS_W + l * W_LAYER + W_OUT), t * 64, red0, wave, lane, tid);
                    const int row = tid >> 4, col = t * 64 + (tid & 15) * 4;
                    const f32x4 o = *(const f32x4*)(HS + row * D + col) + s;
                    *(f32x4*)(HS + row * D + col) = o; v2u w; w.x = pk2(o[0], o[1]); w.y = pk2(o[2], o[3]); *(v2u*)(hsbx + row * D + col) = w;
                    sss_put((float*)(ws + WS_SMP + SMP_SSS) + 512, row, t, o, tid);
                    __syncthreads();
                }
            }
            unsigned char* ws = KWS();
            pg8::Gemm g{(const bf16*)(ws + WS_AO), (const bf16*)(ws + WS_W + l * W_LAYER + W_OUT), M, D, D}; pg8::StaticOrder S; S.init(M, D, G, bx);
            for (int rep = 0; rep < REP_P3; ++rep) {
            pg8::EpiRes E{l, 0, rep < REP_P3 - 1};
            pg8::gemm_phase<pg8::EpiRes, pg8::StaticOrder, false, true>(lds + RING_OFF, g, S, E, wave); }
            SEAM(pb + 2);
        }
        if (IN(pb + 3)) {
            PH_TID();
            for (int rep = 0; rep < REP_S4; ++rep)
            if (bx < DFF / 64) {
                unsigned char* ws = KWS();
                bf16* ACTS = (bf16*)(ws + WS_SMP + SMP_ACTS);
                for (int t = bx; t < DFF / 64; t += G) {
                    const f32x4 s = sg_tile<D>((const bf16*)(ws + WS_SMP + ((l & 1) ? SMP_HSB1 : SMP_HSB0)), (const bf16*)(ws + WS_W + l * W_LAYER + W_UP), t * 64, red0, wave, lane, tid) * srstd((const float*)(ws + WS_SMP + SMP_SSS) + 512, tid >> 4);
                    const int row = tid >> 4, col = t * 64 + (tid & 15) * 4;
                    const float a0 = fmaxf(s[0], 0.f), a1 = fmaxf(s[1], 0.f), a2 = fmaxf(s[2], 0.f), a3 = fmaxf(s[3], 0.f);
                    v2u w; w.x = pk2(a0 * a0, a1 * a1); w.y = pk2(a2 * a2, a3 * a3); *(v2u*)(ACTS + row * DFF + col) = w;
                    __syncthreads();
                }
            }
            unsigned char* ws = KWS();
            pg8::Gemm g{(const bf16*)(ws + ((l & 1) ? WS_HB1 : WS_HB0)), (const bf16*)(ws + WS_W + l * W_LAYER + W_UP), M, DFF, D}; pg8::StaticOrder S; S.init(M, DFF, G, bx);
            pg8::EpiUp E{l};
            for (int rep = 0; rep < REP_P4; ++rep)
            pg8::gemm_phase<pg8::EpiUp, pg8::StaticOrder, true, true>(lds + RING_OFF, g, S, E, wave);
            SEAM(pb + 3);
        }
        if (IN(pb + 4)) {
            PH_TID();
            if (bx < D / 64) {
                unsigned char* ws = KWS();
                float* HS = (float*)(ws + WS_SMP + SMP_HS); bf16* hsbx = (bf16*)(ws + WS_SMP + ((l & 1) ? SMP_HSB1 : SMP_HSB0));
                for (int t = bx; t < D / 64; t += G) {
                    const f32x4 s = sg_tile<DFF>((const bf16*)(ws + WS_SMP + SMP_ACTS), (const bf16*)(ws + WS_W + l * W_LAYER + W_DN), t * 64, red0, wave, lane, tid);
                    const int row = tid >> 4, col = t * 64 + (tid & 15) * 4;
                    const f32x4 o = *(const f32x4*)(HS + row * D + col) + s;
                    *(f32x4*)(HS + row * D + col) = o; v2u w; w.x = pk2(o[0], o[1]); w.y = pk2(o[2], o[3]); *(v2u*)(hsbx + row * D + col) = w;
                    sss_put((float*)(ws + WS_SMP + SMP_SSS) + 1024, row, t, o, tid);
                    __syncthreads();
                }
            }
            unsigned char* ws = KWS();
            pg8::Gemm g{(const bf16*)(ws + WS_ACT), (const bf16*)(ws + WS_W + l * W_LAYER + W_DN), M, D, DFF}; pg8::StaticOrder S; S.init(M, D, G, bx);
            for (int rep = 0; rep < REP_P5; ++rep) {
            pg8::EpiRes E{l, 1, rep < REP_P5 - 1};
            pg8::gemm_phase<pg8::EpiRes, pg8::StaticOrder, false, true>(lds + RING_OFF, g, S, E, wave); }
            SEAM(pb + 4);
        }
        if (IN(pb + 5)) {
            PH_TID();
            if (bx < D / 64) {
                unsigned char* ws = KWS();
                float* HS = (float*)(ws + WS_SMP + SMP_HS); bf16* hsby = (bf16*)(ws + WS_SMP + ((l & 1) ? SMP_HSB0 : SMP_HSB1));
                for (int t = bx; t < D / 64; t += G) {
                    const f32x4 gt = sg_tile<D>((const bf16*)(ws + WS_SMP + ((l & 1) ? SMP_HSB1 : SMP_HSB0)), (const bf16*)(ws + WS_W + l * W_LAYER + W_GT), t * 64, red0, wave, lane, tid) * (srstd((const float*)(ws + WS_SMP + SMP_SSS) + 1024, tid >> 4) * -1.4426950408889634f);
                    const f32x4 pe = sg_tile<DPLE>((const bf16*)(ws + WS_SMP + SMP_PSB) + (size_t)l * SB * DPLE, (const bf16*)(ws + WS_W + l * W_LAYER + W_PL), t * 64, red1, wave, lane, tid);
                    const int row = tid >> 4, col = t * 64 + (tid & 15) * 4;
                    f32x4 o = *(const f32x4*)(HS + row * D + col);
#pragma unroll
                    for (int e = 0; e < 4; ++e) o[e] += pe[e] * __builtin_amdgcn_rcpf(1.0f + __builtin_amdgcn_exp2f(gt[e]));
                    *(f32x4*)(HS + row * D + col) = o; v2u w; w.x = pk2(o[0], o[1]); w.y = pk2(o[2], o[3]); *(v2u*)(hsby + row * D + col) = w;
                    sss_put((float*)(ws + WS_SMP + SMP_SSS), row, t, o, tid);
                    __syncthreads();
                }
            }
            { unsigned char* ws = KWS();
              pg8::Gemm g{(const bf16*)(ws + WS_PB) + (size_t)l * M * DPLE, (const bf16*)(ws + WS_W + l * W_LAYER + W_PL), M, D, DPLE}; pg8::StaticOrder S; S.init(M, D, G, bx);
              pg8::EpiPlain E{D};
              for (int rep = 0; rep < REP_PE; ++rep)
              pg8::gemm_phase<pg8::EpiPlain, pg8::StaticOrder, false, true>(lds + RING_OFF, g, S, E, wave); }
            { unsigned char* ws = KWS();
              pg8::Gemm g{(const bf16*)(ws + ((l & 1) ? WS_HB1 : WS_HB0)), (const bf16*)(ws + WS_W + l * W_LAYER + W_GT), M, D, D}; pg8::StaticOrder S; S.init(M, D, G, bx);
              for (int rep = 0; rep < REP_P6; ++rep) {
              pg8::EpiGate E{l, rep < REP_P6 - 1};
              pg8::gemm_phase<pg8::EpiGate, pg8::StaticOrder, false, true>(lds + RING_OFF, g, S, E, wave); } }
            SEAM(pb + 5);
        }
}
__global__ void __launch_bounds__(NWAVES * 64, 2) fwd(Args args) {
    extern __shared__ __attribute__((aligned(16))) unsigned char lds_raw[];
    LAS unsigned char* lds = (LAS unsigned char*)lds_raw;
    volatile LAS unsigned* MISC = (volatile LAS unsigned*)(lds + MISC_OFF);
    const int tid0 = threadIdx.x, wave = __builtin_amdgcn_readfirstlane(tid0 >> 6);
    const int G = gridDim.x, bx = blockIdx.x;
    for (int u = tid0; u < (LDS_BYTES - LDSCTL_OFF) / 4; u += NWAVES * 64) ((LAS unsigned*)(lds + LDSCTL_OFF))[u] = 0u;
    __syncthreads();
    const int lo = args.ph_lo, hi = args.ph_hi;
    XcdBarrier bar; bar.bar = nullptr; bar.x = 0; bar.st = MISC + 8;
    if (hi - lo > 1) bar = xcd_barrier_post((unsigned*)(KWS() + WS_CTL) + CW_BAR, MISC + 8);
    LAS float* red0 = (LAS float*)(lds + RING_OFF); LAS float* red1 = (LAS float*)(lds + RING_OFF + 65536);

    if (IN(0)) {
            PH_TID();
        for (int rep = 0; rep < REP_P0; ++rep) {
        const int vcu = (G % 8 == 0) ? (bx % 8) * (G / 8) + bx / 8 : bx;
        const int gw = vcu * NWAVES + wave, NGW = G * NWAVES;
        unsigned char* ws = KWS();
        LAS float* scr = (LAS float*)(lds + RING_OFF + wave * 16384);
        constexpr int I_FOLD = 256, I_IN = 1024, I_OUT = 256, I_UP = 2048, I_DN = 2048, I_GT = 512, I_PL = 128, I_REST = I_IN + I_OUT + I_UP + I_DN + I_GT + I_PL;
        { const float* pool_w = KIN(8); const float* pool_scale = KIN(9); const float* w_out = KIN(10);
          for (int it = (gw & 1) ? NL * I_FOLD : (gw >> 1); it < NL * I_FOLD; it += NGW / 2) { const int l = it / I_FOLD, r = it % I_FOLD;
            fold_item(pool_w + (size_t)l * 4 * 128 * 128, pool_scale + l * 512, w_out + (size_t)l * 1024 * 1024, (bf16*)(ws + WS_W + l * W_LAYER + W_OUT), scr, r, lane); } }
        for (int it = gw; it < NL * I_REST; it += NGW) { const int l = it / I_REST; int r = it % I_REST;
            unsigned char* wl = ws + WS_W + l * W_LAYER;
            const float* W; int N; const float* g; bf16* WT; int ldk;
            if (r < I_IN) { W = KIN(7) + (size_t)l * 1024 * 2048; N = 2048; g = KIN(6) + l * 1024; WT = (bf16*)(wl + W_IN); ldk = 1024; }
            else if ((r -= I_IN) < I_OUT) { W = KIN(10) + (size_t)l * 1024 * 1024; N = 1024; g = nullptr; WT = (bf16*)(wl + W_OUT); ldk = 1024; }
            else if ((r -= I_OUT) < I_UP) { W = KIN(12) + (size_t)l * 1024 * 4096; N = 4096; g = KIN(11) + l * 1024; WT = (bf16*)(wl + W_UP); ldk = 1024; }
            else if ((r -= I_UP) < I_DN) { W = KIN(13) + (size_t)l * 4096 * 1024; N = 1024; g = nullptr; WT = (bf16*)(wl + W_DN); ldk = 4096; }
            else if ((r -= I_DN) < I_GT) { W = KIN(15) + (size_t)l * 1024 * 1024; N = 1024; g = KIN(14) + l * 1024; WT = (bf16*)(wl + W_GT); ldk = 1024; }
            else { r -= I_GT; W = KIN(16) + (size_t)l * 256 * 1024; N = 1024; g = nullptr; WT = (bf16*)(wl + W_PL); ldk = 256; }
            tr_item(W, N, g, WT, ldk, scr, r, lane); }
        { const float* x_prompt = KIN(0); bf16* HB0 = (bf16*)(ws + WS_HB0); float* SS_A = (float*)(ws + WS_SS);
          for (int m = gw; m < M; m += 2 * NGW) xrow2_item(x_prompt + (size_t)m * D, HB0 + (size_t)m * D, SS_A + (size_t)m * 4, (size_t)NGW, lane); }
        { const float* p_prompt = KIN(4); bf16* PB = (bf16*)(ws + WS_PB);
          for (int it = gw; it < NL * M * DPLE / 2048; it += NGW) cvt_item4(p_prompt, PB, it, lane); }
        { const float* x_sample = KIN(1); unsigned char* smp = ws + WS_SMP;
          for (int m = gw; m < SB; m += NGW) xrow_item(x_sample + (size_t)m * D, (bf16*)(smp + SMP_HSB0) + (size_t)m * D, (float*)(smp + SMP_SSS) + m * 16, 16, (float*)(smp + SMP_HS) + (size_t)m * D, lane);
          const float* p_sample = KIN(5);
          for (int it = gw; it < NL * SB * DPLE / 2048; it += NGW) cvt_item4(p_sample, (bf16*)(smp + SMP_PSB), it, lane); }
        }
        VM_WAIT(); __syncthreads();
        SEAM(0);
    }

    layer_phases<0>(lds, lo, hi, G, bx, wave, bar);
    layer_phases<1>(lds, lo, hi, G, bx, wave, bar);
    layer_phases<2>(lds, lo, hi, G, bx, wave, bar);
    layer_phases<3>(lds, lo, hi, G, bx, wave, bar);
    if (IN(N_PHASES - 1)) {
            PH_TID();
        const int gw = bx * NWAVES + wave, NGW = G * NWAVES;
        unsigned char* ws = KWS(); float* outp = KOUT(); const float* g_final = KIN(17);
        const bf16* HBF = (const bf16*)(ws + ((NL & 1) ? WS_HB1 : WS_HB0)); const float* SS_A = (const float*)(ws + WS_SS);
        for (int m = gw; m < M; m += NGW) final_row_bf(HBF + (size_t)m * D, pg8::row_rstd(SS_A, m), g_final, outp + O_YP + (size_t)m * D, lane);
        for (int m = gw; m < SB; m += NGW) final_row((const float*)(ws + WS_SMP + SMP_HS) + (size_t)m * D, srstd((const float*)(ws + WS_SMP + SMP_SSS), m), g_final, outp + O_YS + (size_t)m * D, lane);
    }
#undef IN
#undef SEAM
}

extern "C" void kernel_launch(void* const* d_in, const int* in_sizes, int n_in, void* d_out, int out_size, void* d_ws, size_t ws_size, hipStream_t stream) {
    static int grid = 0;
    if (grid == 0) {
        if (n_in != 18 || in_sizes[0] != M * D || (size_t)out_size != O_END || ws_size < WS_END) { fprintf(stderr, "kernel_launch: unexpected shapes (n_in %d, in0 %d, out %d, ws %zu); nothing launched\n", n_in, n_in > 0 ? in_sizes[0] : -1, out_size, ws_size); grid = -1; return; }
        int dev = 0, cus = 0, per_cu = 0;
        if (hipGetDevice(&dev) != hipSuccess || hipDeviceGetAttribute(&cus, hipDeviceAttributeMultiprocessorCount, dev) != hipSuccess) { fprintf(stderr, "kernel_launch: device query failed\n"); grid = -1; return; }
        if (hipFuncSetAttribute((const void*)fwd, hipFuncAttributeMaxDynamicSharedMemorySize, LDS_BYTES) != hipSuccess) { fprintf(stderr, "kernel_launch: hipFuncSetAttribute failed\n"); grid = -1; return; }
        if (hipOccupancyMaxActiveBlocksPerMultiprocessor(&per_cu, (const void*)fwd, NWAVES * 64, LDS_BYTES) != hipSuccess || per_cu < 1) fprintf(stderr, "kernel_launch: note: occupancy query reports %d workgroups per CU\n", per_cu);
        (void)hipGetLastError();
        grid = cus;
        if (grid != 256) fprintf(stderr, "kernel_launch: %d CUs: this kernel is built for a 256-CU device\n", grid);
    }
    if (grid < 0) return;
    if (hipMemsetAsync((char*)d_ws + WS_CTL, 0, CTL_ZERO_BYTES, stream) != hipSuccess) { fprintf(stderr, "kernel_launch: memset failed\n"); return; }
    Args a{};
    for (int i = 0; i < 18; ++i) a.in[i] = (const float*)d_in[i];
    a.out = (float*)d_out; a.ws = (unsigned char*)d_ws;
#if MK_SPLIT
    for (int p = 0; p < N_PHASES; ++p) { a.ph_lo = p; a.ph_hi = p + 1; hipLaunchKernelGGL(fwd, dim3(grid), dim3(NWAVES * 64), LDS_BYTES, stream, a); }
#else
    a.ph_lo = 0; a.ph_hi = N_PHASES;
    hipLaunchKernelGGL(fwd, dim3(grid), dim3(NWAVES * 64), LDS_BYTES, stream, a);
#endif
    const hipError_t le = hipPeekAtLastError();
    if (le != hipSuccess) fprintf(stderr, "kernel_launch: launch failed: %s\n", hipGetErrorName(le));
}
```
